# Optimizing an MI355X kernel written in HIP

```python
import math
import jax, jax.numpy as jnp
from jax import lax
import numpy as np

D_MODEL = 2048
BATCH = 4
SEQ = 2048
DEPTH = 2

N_A_LAYERS = DEPTH // 2
N_B_LAYERS = DEPTH - N_A_LAYERS
N_SUBLAYERS = 3
FFN_RESIDUAL_WEIGHT = 0.5
D_FF = 5632
RMS_EPS = 1e-6
ADA_SCALE = 0.1

S5_GROUP = 16
N_S5_GROUPS = D_MODEL // S5_GROUP
S5_STATE = 64
DT_MIN = 1e-3
DT_MAX = 1e-1

HEAD_DIM = 64
N_Q_HEADS = D_MODEL // HEAD_DIM
N_KV_HEADS = N_Q_HEADS // 8
Q_PER_KV = N_Q_HEADS // N_KV_HEADS
WINDOW = 128
ATTN_BLOCK = 128
ROPE_THETA = 10000.0

kernel_name = "yoco_s5_swa_sink_macaron_adaln"


def _rmsnorm(x, g):
    xf = x.astype(jnp.float32)
    xf = xf * lax.rsqrt(jnp.mean(xf * xf, axis=-1, keepdims=True) + RMS_EPS)
    return (xf * g.astype(jnp.float32)).astype(x.dtype)


def _modulate(h, shift, scale):
    return h * (1.0 + scale[:, None, :]) + shift[:, None, :]


def _swiglu(h, w_in, w_out):
    gate, up = jnp.split(h @ w_in, 2, axis=-1)
    return (jax.nn.silu(gate) * up) @ w_out


def _rope_tables(positions):
    inv_freq = 1.0 / (ROPE_THETA ** (jnp.arange(0, HEAD_DIM, 2, dtype=jnp.float32) / HEAD_DIM))
    ang = positions.astype(jnp.float32)[..., None] * inv_freq
    return jnp.cos(ang)[:, :, None, :], jnp.sin(ang)[:, :, None, :]


def _apply_rope(t, cos, sin):
    tf = t.astype(jnp.float32)
    t1, t2 = jnp.split(tf, 2, axis=-1)
    return jnp.concatenate([t1 * cos - t2 * sin, t2 * cos + t1 * sin], axis=-1).astype(t.dtype)


def _s5_mixer(u, w_in, a_re, a_im, b_re, b_im, c_re, c_im, d_skip, log_dt, w_glu, b_glu, w_out):
    Bsz, L, D = u.shape
    v = (u @ w_in).reshape(Bsz, L, N_S5_GROUPS, S5_GROUP).astype(jnp.float32)
    lam = lax.complex(a_re.astype(jnp.float32), a_im.astype(jnp.float32))
    dt = jnp.exp(log_dt.astype(jnp.float32))[:, None]
    lam_bar = jnp.exp(lam * dt)
    b_mat = lax.complex(b_re.astype(jnp.float32), b_im.astype(jnp.float32))
    b_bar = ((lam_bar - 1.0) / lam)[..., None] * b_mat
    c_mat = lax.complex(c_re.astype(jnp.float32), c_im.astype(jnp.float32))
    bu = jnp.einsum('blgh,gph->blgp', v.astype(jnp.complex64), b_bar)
    a_elems = jnp.broadcast_to(lam_bar, (1, L) + lam_bar.shape)

    def combine(left, right):
        a_l, b_l = left
        a_r, b_r = right
        return a_r * a_l, a_r * b_l + b_r

    _, states = lax.associative_scan(combine, (a_elems, bu), axis=1)
    y = jnp.einsum('blgp,ghp->blgh', states, c_mat).real + d_skip.astype(jnp.float32) * v
    y = jax.nn.gelu(y.reshape(Bsz, L, D)).astype(u.dtype)
    y = y * jax.nn.sigmoid(y @ w_glu + b_glu)
    return y @ w_out


def _banded(t):
    Bsz, L = t.shape[:2]
    nb = L // ATTN_BLOCK
    cur = t.reshape(Bsz, nb, ATTN_BLOCK, t.shape[2], t.shape[3])
    prev = jnp.pad(cur[:, :-1], ((0, 0), (1, 0), (0, 0), (0, 0), (0, 0)))
    return jnp.concatenate([prev, cur], axis=2)


def _band_mask(nb):
    q_pos = jnp.arange(ATTN_BLOCK)[:, None] + ATTN_BLOCK
    k_pos = jnp.arange(2 * ATTN_BLOCK)[None, :]
    diff = q_pos - k_pos
    in_window = (diff >= 0) & (diff < WINDOW)
    k_abs = jnp.arange(nb)[:, None] * ATTN_BLOCK - ATTN_BLOCK + k_pos
    return in_window[None] & (k_abs >= 0)[:, None, :]


def _shared_kv(h, c_act, kv_norm_g, w_ada_kv, b_ada_kv, w_kv, cos, sin):
    Bsz, L, _ = h.shape
    shift, scale = jnp.split(c_act @ w_ada_kv + b_ada_kv, 2, axis=-1)
    hn = _modulate(_rmsnorm(h, kv_norm_g), shift, scale)
    k, v = jnp.split(hn @ w_kv, 2, axis=-1)
    k = _apply_rope(k.reshape(Bsz, L, N_KV_HEADS, HEAD_DIM), cos, sin)
    v = v.reshape(Bsz, L, N_KV_HEADS, HEAD_DIM)
    return _banded(k), _banded(v)


def _swa_sink_attention(h, k_band, v_band, mask, cos, sin, w_q, sinks, w_o):
    Bsz, L, _ = h.shape
    nb = L // ATTN_BLOCK
    q = _apply_rope((h @ w_q).reshape(Bsz, L, N_Q_HEADS, HEAD_DIM), cos, sin)
    q = q.reshape(Bsz, nb, ATTN_BLOCK, N_KV_HEADS, Q_PER_KV, HEAD_DIM)
    s = jnp.einsum('bnqhgd,bnkhd->bnhgqk', q, k_band,
                   preferred_element_type=jnp.float32) * (HEAD_DIM ** -0.5)
    s = jnp.where(mask[None, :, None, None], s, -jnp.inf)
    sink = jnp.broadcast_to(sinks.astype(jnp.float32).reshape(1, 1, N_KV_HEADS, Q_PER_KV, 1, 1),
                            s.shape[:-1] + (1,))
    p = jax.nn.softmax(jnp.concatenate([s, sink], axis=-1), axis=-1)[..., :-1]
    o = jnp.einsum('bnhgqk,bnkhd->bnqhgd', p.astype(v_band.dtype), v_band)
    return o.reshape(Bsz, L, N_Q_HEADS * HEAD_DIM) @ w_o


def setup_inputs(seed: int = 0) -> dict:
    key = jax.random.key(seed)
    ks = jax.random.split(key, 32)
    f32 = jnp.float32
    D, F, G, P, H = D_MODEL, D_FF, N_S5_GROUPS, S5_STATE, S5_GROUP
    kvw = N_KV_HEADS * HEAD_DIM
    qw = N_Q_HEADS * HEAD_DIM

    def nrm(k, shape, std):
        return jax.random.normal(k, shape, f32) * std

    x = jax.random.normal(ks[0], (BATCH, SEQ, D), f32)
    c = jax.random.normal(ks[1], (BATCH, D), f32)
    offsets = jax.random.randint(ks[2], (BATCH, 1), 0, 4096, dtype=jnp.int32)
    positions = offsets + jnp.arange(SEQ, dtype=jnp.int32)[None, :]

    norm_g = 1.0 + nrm(ks[3], (DEPTH, N_SUBLAYERS, D), 0.02)
    w_ada = nrm(ks[4], (DEPTH, D, N_SUBLAYERS * 3 * D), ADA_SCALE * D ** -0.5)
    b_ada = nrm(ks[5], (DEPTH, N_SUBLAYERS * 3 * D), 0.01)
    w_ff_in = nrm(ks[6], (DEPTH, 2, D, 2 * F), D ** -0.5)
    w_ff_out = nrm(ks[7], (DEPTH, 2, F, D), F ** -0.5)

    s5_w_in = nrm(ks[8], (N_A_LAYERS, D, D), D ** -0.5)
    n_idx = jnp.arange(P, dtype=f32)
    s5_a_re = -0.5 + nrm(ks[9], (N_A_LAYERS, G, P), 0.01)
    s5_a_im = math.pi * n_idx + nrm(ks[10], (N_A_LAYERS, G, P), 0.01)
    s5_b_re = nrm(ks[11], (N_A_LAYERS, G, P, H), H ** -0.5)
    s5_b_im = nrm(ks[12], (N_A_LAYERS, G, P, H), H ** -0.5)
    s5_c_re = nrm(ks[13], (N_A_LAYERS, G, H, P), P ** -0.5)
    s5_c_im = nrm(ks[14], (N_A_LAYERS, G, H, P), P ** -0.5)
    s5_d = nrm(ks[15], (N_A_LAYERS, G, H), 1.0)
    s5_log_dt = jax.random.uniform(ks[16], (N_A_LAYERS, G), f32,
                                   math.log(DT_MIN), math.log(DT_MAX))
    s5_w_glu = nrm(ks[17], (N_A_LAYERS, D, D), D ** -0.5)
    s5_b_glu = nrm(ks[18], (N_A_LAYERS, D), 0.01)
    s5_w_out = nrm(ks[19], (N_A_LAYERS, D, D), D ** -0.5)

    kv_norm_g = 1.0 + nrm(ks[20], (D,), 0.02)
    w_ada_kv = nrm(ks[21], (D, 2 * D), ADA_SCALE * D ** -0.5)
    b_ada_kv = nrm(ks[22], (2 * D,), 0.01)
    w_kv = nrm(ks[23], (D, 2 * kvw), D ** -0.5)

    attn_w_q = nrm(ks[24], (N_B_LAYERS, D, qw), D ** -0.5)
    attn_sinks = nrm(ks[25], (N_B_LAYERS, N_Q_HEADS), 1.0)
    attn_w_o = nrm(ks[26], (N_B_LAYERS, qw, D), qw ** -0.5)

    final_norm_g = 1.0 + nrm(ks[27], (D,), 0.02)

    return {"x": x, "c": c, "positions": positions,
            "norm_g": norm_g, "w_ada": w_ada, "b_ada": b_ada,
            "w_ff_in": w_ff_in, "w_ff_out": w_ff_out,
            "s5_w_in": s5_w_in, "s5_a_re": s5_a_re, "s5_a_im": s5_a_im,
            "s5_b_re": s5_b_re, "s5_b_im": s5_b_im, "s5_c_re": s5_c_re, "s5_c_im": s5_c_im,
            "s5_d": s5_d, "s5_log_dt": s5_log_dt, "s5_w_glu": s5_w_glu, "s5_b_glu": s5_b_glu,
            "s5_w_out": s5_w_out,
            "kv_norm_g": kv_norm_g, "w_ada_kv": w_ada_kv, "b_ada_kv": b_ada_kv, "w_kv": w_kv,
            "attn_w_q": attn_w_q, "attn_sinks": attn_sinks, "attn_w_o": attn_w_o,
            "final_norm_g": final_norm_g}


def reference(x, c, positions, norm_g, w_ada, b_ada, w_ff_in, w_ff_out,
              s5_w_in, s5_a_re, s5_a_im, s5_b_re, s5_b_im, s5_c_re, s5_c_im,
              s5_d, s5_log_dt, s5_w_glu, s5_b_glu, s5_w_out,
              kv_norm_g, w_ada_kv, b_ada_kv, w_kv,
              attn_w_q, attn_sinks, attn_w_o, final_norm_g):
    Bsz, L, D = x.shape
    c_act = jax.nn.silu(c)
    cos, sin = _rope_tables(positions)
    mask = _band_mask(L // ATTN_BLOCK)
    k_band = v_band = None
    for layer in range(DEPTH):
        mod = (c_act @ w_ada[layer] + b_ada[layer]).reshape(Bsz, N_SUBLAYERS, 3, D)
        shift, scale, gate = mod[:, :, 0], mod[:, :, 1], mod[:, :, 2]
        g = norm_g[layer]
        h = _modulate(_rmsnorm(x, g[0]), shift[:, 0], scale[:, 0])
        x = x + FFN_RESIDUAL_WEIGHT * (1.0 + gate[:, 0, None, :]) * _swiglu(
            h, w_ff_in[layer, 0], w_ff_out[layer, 0])
        h = _modulate(_rmsnorm(x, g[1]), shift[:, 1], scale[:, 1])
        if layer < N_A_LAYERS:
            i = layer
            y = _s5_mixer(h, s5_w_in[i], s5_a_re[i], s5_a_im[i], s5_b_re[i], s5_b_im[i],
                          s5_c_re[i], s5_c_im[i], s5_d[i], s5_log_dt[i],
                          s5_w_glu[i], s5_b_glu[i], s5_w_out[i])
        else:
            j = layer - N_A_LAYERS
            y = _swa_sink_attention(h, k_band, v_band, mask, cos, sin,
                                    attn_w_q[j], attn_sinks[j], attn_w_o[j])
        x = x + (1.0 + gate[:, 1, None, :]) * y
        h = _modulate(_rmsnorm(x, g[2]), shift[:, 2], scale[:, 2])
        x = x + FFN_RESIDUAL_WEIGHT * (1.0 + gate[:, 2, None, :]) * _swiglu(
            h, w_ff_in[layer, 1], w_ff_out[layer, 1])
        if layer == N_A_LAYERS - 1:
            k_band, v_band = _shared_kv(x, c_act, kv_norm_g, w_ada_kv, b_ada_kv, w_kv, cos, sin)
    return _rmsnorm(x, final_norm_g)
```

```cpp
#include <hip/hip_runtime.h>
#include <hip/hip_cooperative_groups.h>
#include <cstdio>
#include <cstdint>
namespace pg8 {
#define PG8_LAS __attribute__((address_space(3)))
typedef unsigned short bf16_t;
typedef short bf16x8 __attribute__((ext_vector_type(8)));
typedef float f32x4 __attribute__((ext_vector_type(4)));
typedef unsigned u32x4 __attribute__((ext_vector_type(4)));
constexpr int BM = 256, BK = 64, HALF = 128, HTB = HALF * BK * 2  , STAGE_BYTES = 8 * HTB, NXCD = 8, WGM = 4;

__host__ __device__ __forceinline__ int lds_byte(int r, int c) { const int st = (r >> 4) * 2 + (c >> 5), rr = r & 15, cc = c & 31, ob = rr * 64 + cc * 2; return st * 1024 + (ob ^ (((ob >> 9) & 1) << 5)); }
__host__ __device__ __forceinline__ void stage_rc(int b, int& R, int& C) { const int st = b / 1024, sb = b % 1024, swz = sb ^ (((sb >> 9) & 1) << 5); R = (st >> 1) * 16 + swz / 64; C = (st & 1) * 32 + (swz % 64) / 2; }
__host__ __device__ __forceinline__ int perm32(int rho) { const int n = rho >> 4, i = rho & 15; return 8 * (i >> 2) + 4 * n + (i & 3); }

struct Unit { int pm, pn; };
struct Gemm { const bf16_t* A; const bf16_t* Bt; int M, N, K; };

struct StaticOrder {
    int nM, nN, nwg, G, c;
    __host__ __device__ void init(int M, int N, int G_, int c_) { nM = M / BM; nN = N / BM; nwg = nM * nN; G = G_; c = c_; }
    __host__ __device__ bool next(int i, Unit& u) const {
        const long L = (long)i * G + c; if (L >= nwg) return false;
        int wgid = (int)L; { const int q = nwg / NXCD, r = nwg % NXCD, xcd = wgid % NXCD, off = wgid / NXCD; wgid = (xcd < r ? xcd * (q + 1) : r * (q + 1) + (xcd - r) * q) + off; }
        const int nig = WGM * nN, gid = wgid / nig, fm = gid * WGM, gsz = (nM - fm) < WGM ? (nM - fm) : WGM;
        u.pm = fm + ((wgid % nig) % gsz); u.pn = (wgid % nig) / gsz; return true;
    }
    __device__ __forceinline__ void a_ready(const Unit&) const {}
    __device__ __forceinline__ void done(const Unit&) const {}
};

__device__ __forceinline__ unsigned cvt_pk_bf16(float lo, float hi) { unsigned r; asm volatile("v_cvt_pk_bf16_f32 %0, %1, %2" : "=v"(r) : "v"(lo), "v"(hi)); return r; }
typedef float f32x2 __attribute__((ext_vector_type(2)));
template <class Epi, class Sched, bool ALIGN_EPI = false, bool SP2 = false>
__device__ __forceinline__ void gemm_phase(PG8_LAS unsigned char* lds, const Gemm g, const Sched& S, const Epi& E) {
    int tid_ = threadIdx.x; asm volatile("" : "+v"(tid_));
    const int tid = tid_, wid = __builtin_amdgcn_readfirstlane(tid >> 6), lane = tid & 63, wr = wid >> 2, wc = wid & 3, fr = lane & 15, fq = lane >> 4;
    const int K = g.K, nt = K / BK;
    unsigned voffA[2], voffB[2];
#pragma unroll
    for (int i = 0; i < 2; ++i) { int R, C; stage_rc(tid * 16 + i * 8192, R, C); const int Rb = Epi::PERM ? ((R & ~31) + perm32(R & 31)) : R;
        voffA[i] = (unsigned)(R * K + C) * 2u; voffB[i] = (unsigned)(Rb * K + C) * 2u; }
    const size_t kstep = (size_t)(BK * 2);
    const size_t hstep = (size_t)HALF * K * 2;
    const size_t tstep = 2 * hstep;
    const unsigned ldsw = (unsigned)wid * 1024u;
    const int aoff = lds_byte(wr * 64 + fr, fq * 8), boff = lds_byte(wc * 32 + fr, fq * 8);
#define PG8_SA(b, h) (((b) * 2 + (h)) * HTB)
#define PG8_SB(b, h) ((4 + (b) * 2 + (h)) * HTB)
#define PG8_STAGE(bufoff, gbase, voff) do { _Pragma("unroll") for (int _i = 0; _i < 2; ++_i) \
        __builtin_amdgcn_global_load_lds((const unsigned*)((const char*)(gbase) + (voff)[_i]), (PG8_LAS unsigned*)(lds + (bufoff) + ldsw + _i * 8192), 16, 0, 0); } while (0)
#define PG8_LDA(dst, b, h) do { _Pragma("unroll") for (int m = 0; m < 4; ++m) _Pragma("unroll") for (int k = 0; k < 2; ++k) dst[m][k] = *(const PG8_LAS bf16x8*)(lds + PG8_SA(b, h) + aoff + m * 2048 + k * 1024); } while (0)
#define PG8_LDB(dst, b, h) do { _Pragma("unroll") for (int n = 0; n < 2; ++n) _Pragma("unroll") for (int k = 0; k < 2; ++k) dst[n][k] = *(const PG8_LAS bf16x8*)(lds + PG8_SB(b, h) + boff + n * 2048 + k * 1024); } while (0)
#define PG8_MMA(ai, bj, At, Bt) do { __builtin_amdgcn_s_setprio(1); _Pragma("unroll") for (int m = 0; m < 4; ++m) _Pragma("unroll") for (int n = 0; n < 2; ++n) _Pragma("unroll") for (int k = 0; k < 2; ++k) \
        acc[ai][bj][m][n] = __builtin_amdgcn_mfma_f32_16x16x32_bf16(Bt[n][k], At[m][k], acc[ai][bj][m][n], 0, 0, 0); __builtin_amdgcn_s_setprio(0); } while (0)
#define PG8_WAIT_V(n) asm volatile("s_waitcnt vmcnt(" #n ")" ::: "memory")
#define PG8_WAIT_L(n) asm volatile("s_waitcnt lgkmcnt(" #n ")" ::: "memory")
#define PG8_BAR __builtin_amdgcn_s_barrier()
#define PG8_SCHED __builtin_amdgcn_sched_barrier(0)
    Unit cur, nxt; int ui = 0;
    if (!S.next(0, cur)) return;
    f32x4 acc[2][2][4][2];
#pragma unroll
    for (int a = 0; a < 2; ++a)
#pragma unroll
        for (int b = 0; b < 2; ++b)
#pragma unroll
            for (int m = 0; m < 4; ++m)
#pragma unroll
                for (int n = 0; n < 2; ++n) acc[a][b][m][n] = (f32x4){0.f, 0.f, 0.f, 0.f};
    bf16x8 At[4][2], B0[2][2], B1[2][2];
    const char* cA = (const char*)g.A + (size_t)cur.pm * tstep; const char* cB = (const char*)g.Bt + (size_t)cur.pn * tstep;
    S.a_ready(cur);
    if constexpr (SP2) {
        PG8_STAGE(PG8_SB(0, 0), cB, voffB); PG8_STAGE(PG8_SB(0, 1), cB + hstep, voffB); PG8_STAGE(PG8_SA(0, 0), cA, voffA); PG8_STAGE(PG8_SA(0, 1), cA + hstep, voffA);
        if (wr == 1) PG8_BAR;
        PG8_WAIT_V(2); PG8_BAR;
        PG8_STAGE(PG8_SB(1, 0), cB + kstep, voffB); PG8_STAGE(PG8_SA(1, 0), cA + kstep, voffA); PG8_STAGE(PG8_SB(1, 1), cB + hstep + kstep, voffB);
        PG8_WAIT_V(6); PG8_BAR;
    } else {
        PG8_STAGE(PG8_SB(0, 0), cB, voffB); PG8_STAGE(PG8_SA(0, 0), cA, voffA); PG8_STAGE(PG8_SB(0, 1), cB + hstep, voffB); PG8_STAGE(PG8_SA(0, 1), cA + hstep, voffA);
        if (wr == 1) PG8_BAR;
        PG8_WAIT_V(4); PG8_BAR;
        PG8_STAGE(PG8_SB(1, 0), cB + kstep, voffB); PG8_STAGE(PG8_SA(1, 0), cA + kstep, voffA); PG8_STAGE(PG8_SB(1, 1), cB + hstep + kstep, voffB);
        PG8_WAIT_V(6); PG8_BAR;
    }
    for (;;) {
        const bool has_next = S.next(ui + 1, nxt);
        const char* nA = has_next ? (const char*)g.A + (size_t)nxt.pm * tstep : cA; const char* nB = has_next ? (const char*)g.Bt + (size_t)nxt.pn * tstep : cB;
        for (int t = 0; t < nt; t += 2) {
            const bool last = (t == nt - 2);
            const char* a1 = cA + (size_t)(t + 1) * kstep;
            const char* a2 = last ? nA : cA + (size_t)(t + 2) * kstep; const char* b2 = last ? nB : cB + (size_t)(t + 2) * kstep;
            const char* a3 = a2 + kstep; const char* b3 = b2 + kstep;
            if (last && has_next) S.a_ready(nxt);
            if constexpr (SP2) {
            PG8_LDB(B0, 0, 0); PG8_LDB(B1, 0, 1); PG8_SCHED; PG8_LDA(At, 0, 0); PG8_STAGE(PG8_SA(1, 1), a1 + hstep, voffA);
            PG8_WAIT_V(8); PG8_WAIT_L(0); PG8_BAR; PG8_MMA(0, 0, At, B0); PG8_MMA(0, 1, At, B1); PG8_BAR; PG8_SCHED;
            PG8_LDA(At, 0, 1); PG8_STAGE(PG8_SB(0, 0), b2, voffB); PG8_STAGE(PG8_SB(0, 1), b2 + hstep, voffB); PG8_STAGE(PG8_SA(0, 0), a2, voffA);
            PG8_WAIT_V(8); PG8_WAIT_L(0); PG8_BAR; PG8_MMA(1, 0, At, B0); PG8_MMA(1, 1, At, B1); PG8_BAR; PG8_SCHED;
            PG8_LDB(B0, 1, 0); PG8_LDB(B1, 1, 1); PG8_SCHED; PG8_LDA(At, 1, 0); PG8_STAGE(PG8_SA(0, 1), a2 + hstep, voffA);
            PG8_WAIT_V(8); PG8_WAIT_L(0); PG8_BAR; PG8_MMA(0, 0, At, B0); PG8_MMA(0, 1, At, B1); PG8_BAR; PG8_SCHED;
            PG8_LDA(At, 1, 1); PG8_STAGE(PG8_SB(1, 0), b3, voffB); PG8_STAGE(PG8_SB(1, 1), b3 + hstep, voffB); PG8_STAGE(PG8_SA(1, 0), a3, voffA);
            PG8_WAIT_V(8); PG8_WAIT_L(0); PG8_BAR; PG8_MMA(1, 0, At, B0); PG8_MMA(1, 1, At, B1); PG8_BAR; PG8_SCHED;
            } else {
            PG8_LDB(B0, 0, 0); PG8_SCHED; PG8_LDA(At, 0, 0); PG8_STAGE(PG8_SA(1, 1), a1 + hstep, voffA);
            PG8_WAIT_L(8); PG8_BAR; PG8_WAIT_L(0); PG8_MMA(0, 0, At, B0); PG8_BAR; PG8_SCHED;
            PG8_LDB(B1, 0, 1); PG8_STAGE(PG8_SB(0, 0), b2, voffB);
            PG8_BAR; PG8_WAIT_L(0); PG8_MMA(0, 1, At, B1); PG8_BAR;
            PG8_LDA(At, 0, 1); PG8_STAGE(PG8_SA(0, 0), a2, voffA);
            PG8_BAR; PG8_WAIT_L(0); PG8_MMA(1, 0, At, B0); PG8_BAR; PG8_SCHED;
            PG8_STAGE(PG8_SB(0, 1), b2 + hstep, voffB);
            PG8_WAIT_V(6); PG8_BAR; PG8_MMA(1, 1, At, B1); PG8_BAR;
            PG8_LDB(B0, 1, 0); PG8_SCHED; PG8_LDA(At, 1, 0); PG8_STAGE(PG8_SA(0, 1), a2 + hstep, voffA);
            PG8_WAIT_L(8); PG8_BAR; PG8_WAIT_L(0); PG8_MMA(0, 0, At, B0); PG8_BAR; PG8_SCHED;
            PG8_LDB(B1, 1, 1); PG8_STAGE(PG8_SB(1, 0), b3, voffB);
            PG8_BAR; PG8_WAIT_L(0); PG8_MMA(0, 1, At, B1); PG8_BAR;
            PG8_LDA(At, 1, 1); PG8_STAGE(PG8_SA(1, 0), a3, voffA);
            PG8_BAR; PG8_WAIT_L(0); PG8_MMA(1, 0, At, B0); PG8_BAR; PG8_SCHED;
            PG8_STAGE(PG8_SB(1, 1), b3 + hstep, voffB);
            PG8_WAIT_V(6); PG8_BAR; PG8_MMA(1, 1, At, B1); PG8_BAR;
            }
        }
        if constexpr (ALIGN_EPI) { if (wr == 0) PG8_BAR; }
        if constexpr (!Epi::AFTER_DRAIN) { E(acc, cur, wr, wc, fr, fq); S.done(cur); }
        if (!has_next) break;
#pragma unroll
        for (int a = 0; a < 2; ++a)
#pragma unroll
            for (int b = 0; b < 2; ++b)
#pragma unroll
                for (int m = 0; m < 4; ++m)
#pragma unroll
                    for (int n = 0; n < 2; ++n) acc[a][b][m][n] = (f32x4){0.f, 0.f, 0.f, 0.f};
        cur = nxt; cA = nA; cB = nB; ++ui;
        if constexpr (ALIGN_EPI) { if (wr == 1) PG8_BAR; }
    }
    PG8_WAIT_V(0);
    if constexpr (!ALIGN_EPI) { if (wr == 0) PG8_BAR; }
    PG8_BAR;
    if constexpr (Epi::AFTER_DRAIN) { E.fused(acc, cur, wr, wc, fr, fq, lds, wid, lane); S.done(cur); }
#undef PG8_SA
#undef PG8_SB
#undef PG8_STAGE
#undef PG8_LDA
#undef PG8_LDB
#undef PG8_MMA
#undef PG8_WAIT_V
#undef PG8_WAIT_L
#undef PG8_BAR
#undef PG8_SCHED
}
}

namespace cg = cooperative_groups;
#define LAS __attribute__((address_space(3)))
typedef unsigned short bf16_t;
typedef short bf16x8 __attribute__((ext_vector_type(8)));
typedef float f32x4 __attribute__((ext_vector_type(4)));
typedef float f32x2 __attribute__((ext_vector_type(2)));
typedef unsigned u32x4 __attribute__((ext_vector_type(4)));
typedef unsigned u32x2 __attribute__((ext_vector_type(2)));

constexpr int BATCH = 4, SEQ = 2048, D = 2048, FF = 5632, M = BATCH * SEQ;
constexpr int NG = 128, SP = 64, SH = 16;
constexpr int NQH = 32, NKVH = 4, HD = 64, KVW = 256;
constexpr int MODW = 9 * D;
constexpr int NWAVES = 8, NTHR = 512;
constexpr int LDS_BYTES = 147456;

constexpr size_t MiB = 1u << 20;
constexpr size_t WS_MOD0 = 0, WS_MOD1 = MiB / 2, WS_MODKV = 1 * MiB;
constexpr size_t WS_COS = 2 * MiB, WS_SIN = 3 * MiB, WS_LAM = 4 * MiB, WS_BBAR = 5 * MiB;
constexpr size_t WS_BAR = 4 * MiB + 524288;
constexpr size_t WS_GFLAG = 4 * MiB + 524288 + 32768;
constexpr size_t WS_CTL = 6 * MiB, WS_XBUF = 6 * MiB + 65536;
constexpr size_t WS_WFFIN = 8 * MiB;
constexpr size_t WS_WFFOUT = 184 * MiB;
constexpr size_t WS_WS5IN = 272 * MiB, WS_WS5GLU = 280 * MiB, WS_WS5OUT = 288 * MiB, WS_WQ = 296 * MiB, WS_WO = 304 * MiB, WS_WKV = 312 * MiB;
constexpr size_t WS_X = 320 * MiB;
constexpr size_t WS_XN = 384 * MiB, WS_XN2 = 416 * MiB;
constexpr size_t WS_H = 448 * MiB;
constexpr size_t WS_V = 536 * MiB;
constexpr size_t WS_Y = 600 * MiB, WS_Z = 632 * MiB, WS_Q = 664 * MiB, WS_O = 696 * MiB;
constexpr size_t WS_K = 728 * MiB, WS_VB = 732 * MiB;
constexpr size_t WS_END = 736 * MiB;

__device__ __forceinline__ float bf2f(unsigned short h) { return __uint_as_float(((unsigned)h) << 16); }
__device__ __forceinline__ float bflo(unsigned w) { return __uint_as_float(w << 16); }
__device__ __forceinline__ float bfhi(unsigned w) { return __uint_as_float(w & 0xffff0000u); }
__device__ __forceinline__ unsigned f2bf(float f) { unsigned u = __float_as_uint(f); return (u + 0x7fffu + ((u >> 16) & 1u)) >> 16; }
__device__ __forceinline__ unsigned pk2(float lo, float hi) { return f2bf(lo) | (f2bf(hi) << 16); }
__device__ __forceinline__ float fast_sigmoid(float x) { return __builtin_amdgcn_rcpf(1.0f + __builtin_amdgcn_exp2f(-1.4426950408889634f * x)); }
__device__ __forceinline__ float gelu_tanh(float x) { const float u = 0.7978845608028654f * (x + 0.044715f * x * x * x); return x * fast_sigmoid(2.0f * u); }
__device__ __forceinline__ f32x2 cmul(f32x2 a, f32x2 b) { return (f32x2){a.x * b.x - a.y * b.y, a.x * b.y + a.y * b.x}; }
__device__ __forceinline__ float wave_sum(float v) {
#pragma unroll
    for (int o = 1; o < 64; o <<= 1) v += __shfl_xor(v, o);
    return v;
}
__device__ __forceinline__ void sincos_d(double x, double& s, double& c) {
    const double k = __builtin_rint(x * 0.15915494309189535);
    double r = __builtin_fma(-k, 6.283185307179586, x); r = __builtin_fma(-k, 2.4492935982947064e-16, r);
    const double r2 = r * r;
    double ts = r, tc = 1.0, ss = r, cc = 1.0;
#pragma unroll
    for (int n = 1; n <= 14; ++n) {
        tc = -tc * r2 * (1.0 / (double)((2 * n - 1) * (2 * n)));
        ts = -ts * r2 * (1.0 / (double)((2 * n) * (2 * n + 1)));
        cc += tc; ss += ts;
    }
    s = ss; c = cc;
}
__device__ __forceinline__ double exp_d(double x) {
    const double k = __builtin_rint(x * 1.4426950408889634);
    double r = __builtin_fma(-k, 0.6931471805599453, x); r = __builtin_fma(-k, 2.3190468138462996e-17, r);
    double t = 1.0, e = 1.0;
#pragma unroll
    for (int n = 1; n <= 16; ++n) { t = t * r * (1.0 / (double)n); e += t; }
    return __builtin_ldexp(e, (int)k);
}

struct EpiSwiGLU {
    static constexpr bool PERM = true, AFTER_DRAIN = false;
    bf16_t* H;
    __device__ __forceinline__ void operator()(const f32x4 (&acc)[2][2][4][2], const pg8::Unit& u, int wr, int wc, int fr, int fq) const {
        const int row0 = u.pm * 256 + wr * 64 + fr, col0 = u.pn * 128 + wc * 32 + 8 * fq;
#pragma unroll
        for (int ai = 0; ai < 2; ++ai)
#pragma unroll
            for (int m = 0; m < 4; ++m) {
                bf16_t* rowp = H + (size_t)(row0 + ai * 128 + m * 16) * FF + col0;
                float h[8];
#pragma unroll
                for (int n = 0; n < 2; ++n)
#pragma unroll
                    for (int i = 0; i < 4; ++i) { const float g = acc[ai][0][m][n][i], up = acc[ai][1][m][n][i]; h[4 * n + i] = g * fast_sigmoid(g) * up; }
                u32x4 w; w.x = pg8::cvt_pk_bf16(h[0], h[1]); w.y = pg8::cvt_pk_bf16(h[2], h[3]); w.z = pg8::cvt_pk_bf16(h[4], h[5]); w.w = pg8::cvt_pk_bf16(h[6], h[7]);
                *(u32x4*)rowp = w;
            }
    }
};
struct EpiResid {
    static constexpr bool PERM = false, AFTER_DRAIN = false;
    const float* base; float* out; const float* gate; float coef;
    __device__ __forceinline__ void operator()(const f32x4 (&acc)[2][2][4][2], const pg8::Unit& u, int wr, int wc, int fr, int fq) const {
        const int row0 = u.pm * 256 + wr * 64 + fr, col0 = u.pn * 256 + wc * 32 + 4 * fq;
        const float* gp = gate + (size_t)(u.pm >> 3) * MODW + col0;
        f32x4 gv[2][2];
#pragma unroll
        for (int bj = 0; bj < 2; ++bj)
#pragma unroll
            for (int n = 0; n < 2; ++n) { const f32x4 t = *(const f32x4*)(gp + bj * 128 + n * 16); gv[bj][n] = (t + 1.0f) * coef; }
#pragma unroll
        for (int ai = 0; ai < 2; ++ai)
#pragma unroll
            for (int m = 0; m < 4; ++m) {
                const size_t off = (size_t)(row0 + ai * 128 + m * 16) * D + col0;
#pragma unroll
                for (int bj = 0; bj < 2; ++bj)
#pragma unroll
                    for (int n = 0; n < 2; ++n) { const f32x4 x = *(const f32x4*)(base + off + bj * 128 + n * 16); *(f32x4*)(out + off + bj * 128 + n * 16) = x + gv[bj][n] * acc[ai][bj][m][n]; }
                asm volatile("" ::: "memory");
            }
    }
};
struct EpiF32 {
    static constexpr bool PERM = false, AFTER_DRAIN = false;
    float* out;
    __device__ __forceinline__ void operator()(const f32x4 (&acc)[2][2][4][2], const pg8::Unit& u, int wr, int wc, int fr, int fq) const {
        const int row0 = u.pm * 256 + wr * 64 + fr, col0 = u.pn * 256 + wc * 32 + 4 * fq;
#pragma unroll
        for (int ai = 0; ai < 2; ++ai)
#pragma unroll
            for (int m = 0; m < 4; ++m) {
                const size_t off = (size_t)(row0 + ai * 128 + m * 16) * D + col0;
#pragma unroll
                for (int bj = 0; bj < 2; ++bj)
#pragma unroll
                    for (int n = 0; n < 2; ++n) *(f32x4*)(out + off + bj * 128 + n * 16) = acc[ai][bj][m][n];
            }
    }
};
struct EpiGLU {
    static constexpr bool PERM = true, AFTER_DRAIN = false;
    const bf16_t* Y; bf16_t* Z; const float* bias;
    __device__ __forceinline__ void operator()(const f32x4 (&acc)[2][2][4][2], const pg8::Unit& u, int wr, int wc, int fr, int fq) const {
        const int row0 = u.pm * 256 + wr * 64 + fr, col0 = u.pn * 256 + wc * 32 + 8 * fq;
        f32x4 bv[2][2];
#pragma unroll
        for (int bj = 0; bj < 2; ++bj)
#pragma unroll
            for (int n = 0; n < 2; ++n) bv[bj][n] = *(const f32x4*)(bias + col0 + bj * 128 + 4 * n);
#pragma unroll
        for (int ai = 0; ai < 2; ++ai)
#pragma unroll
            for (int m = 0; m < 4; ++m) {
                const size_t off = (size_t)(row0 + ai * 128 + m * 16) * D + col0;
#pragma unroll
                for (int bj = 0; bj < 2; ++bj) {
                    const u32x4 yv = *(const u32x4*)(Y + off + bj * 128);
                    const f32x4 a0 = acc[ai][bj][m][0] + bv[bj][0], a1 = acc[ai][bj][m][1] + bv[bj][1];
                    u32x4 w;
                    w.x = pg8::cvt_pk_bf16(bflo(yv.x) * fast_sigmoid(a0[0]), bfhi(yv.x) * fast_sigmoid(a0[1]));
                    w.y = pg8::cvt_pk_bf16(bflo(yv.y) * fast_sigmoid(a0[2]), bfhi(yv.y) * fast_sigmoid(a0[3]));
                    w.z = pg8::cvt_pk_bf16(bflo(yv.z) * fast_sigmoid(a1[0]), bfhi(yv.z) * fast_sigmoid(a1[1]));
                    w.w = pg8::cvt_pk_bf16(bflo(yv.w) * fast_sigmoid(a1[2]), bfhi(yv.w) * fast_sigmoid(a1[3]));
                    *(u32x4*)(Z + off + bj * 128) = w;
                }
                asm volatile("" ::: "memory");
            }
    }
};
struct EpiRope {
    static constexpr bool PERM = true, AFTER_DRAIN = false;
    bf16_t* out0; int ld0; bf16_t* out1; int ld1; int n_rope; const float* cosT; const float* sinT; float scale;
    __device__ __forceinline__ void operator()(const f32x4 (&acc)[2][2][4][2], const pg8::Unit& u, int wr, int wc, int fr, int fq) const {
        const int row0 = u.pm * 256 + wr * 64 + fr;
        if (u.pn < n_rope) {
            const int head = 4 * u.pn + wc;
#pragma unroll
            for (int ai = 0; ai < 2; ++ai)
#pragma unroll
                for (int m = 0; m < 4; ++m) {
                    const int row = row0 + ai * 128 + m * 16;
                    float o1[8], o2[8];
#pragma unroll
                    for (int n = 0; n < 2; ++n) {
                        const f32x4 cs = *(const f32x4*)(cosT + (size_t)row * 32 + 8 * fq + 4 * n), sn = *(const f32x4*)(sinT + (size_t)row * 32 + 8 * fq + 4 * n);
                        const f32x4 t1 = acc[ai][0][m][n], t2 = acc[ai][1][m][n];
#pragma unroll
                        for (int i = 0; i < 4; ++i) { o1[4 * n + i] = (t1[i] * cs[i] - t2[i] * sn[i]) * scale; o2[4 * n + i] = (t2[i] * cs[i] + t1[i] * sn[i]) * scale; }
                    }
                    bf16_t* rp = out0 + (size_t)row * ld0 + 64 * head + 8 * fq;
                    u32x4 w; w.x = pg8::cvt_pk_bf16(o1[0], o1[1]); w.y = pg8::cvt_pk_bf16(o1[2], o1[3]); w.z = pg8::cvt_pk_bf16(o1[4], o1[5]); w.w = pg8::cvt_pk_bf16(o1[6], o1[7]);
                    *(u32x4*)rp = w;
                    w.x = pg8::cvt_pk_bf16(o2[0], o2[1]); w.y = pg8::cvt_pk_bf16(o2[2], o2[3]); w.z = pg8::cvt_pk_bf16(o2[4], o2[5]); w.w = pg8::cvt_pk_bf16(o2[6], o2[7]);
                    *(u32x4*)(rp + 32) = w;
                    asm volatile("" ::: "memory");
                }
        } else {
            const int col0 = (u.pn - n_rope) * 256 + wc * 32 + 8 * fq;
#pragma unroll
            for (int ai = 0; ai < 2; ++ai)
#pragma unroll
                for (int m = 0; m < 4; ++m) {
                    bf16_t* rp = out1 + (size_t)(row0 + ai * 128 + m * 16) * ld1 + col0;
#pragma unroll
                    for (int bj = 0; bj < 2; ++bj) {
                        const f32x4 v0 = acc[ai][bj][m][0], v1 = acc[ai][bj][m][1];
                        u32x4 w; w.x = pg8::cvt_pk_bf16(v0[0], v0[1]); w.y = pg8::cvt_pk_bf16(v0[2], v0[3]); w.z = pg8::cvt_pk_bf16(v1[0], v1[1]); w.w = pg8::cvt_pk_bf16(v1[2], v1[3]);
                        *(u32x4*)(rp + bj * 128) = w;
                    }
                    asm volatile("" ::: "memory");
                }
        }
    }
};


struct EpiResidNorm {
    static constexpr bool PERM = false, AFTER_DRAIN = true;
    const float* base; float* out; const float* gate;
    int sidx;
    const float* normg; const float* fing; const float* sh1; const float* sc1; int bs1; bf16_t* o1;
    const float* g2; const float* sh2; const float* sc2; int bs2; bf16_t* o2;
    float* outf;
    unsigned* xbuf; unsigned* cnt;
    __device__ __forceinline__ void fused(f32x4 (&acc)[2][2][4][2], const pg8::Unit& u, int wr, int wc, int fr, int fq, PG8_LAS unsigned char* lds, int wid, int lane) const {
        const int mode = (sidx == 5) ? 2 : ((sidx == 2) ? 1 : 0);
        const float coef = (sidx % 3 != 1) ? 0.5f : 1.0f;
        const float* g1 = (sidx == 5) ? fing : normg + (size_t)(sidx + 1) * D;
        PG8_LAS float* P = (PG8_LAS float*)lds;
        PG8_LAS float* S = (PG8_LAS float*)(lds + 4096);
        const int b = u.pm >> 3, row0 = u.pm * 256 + wr * 64 + fr, col0 = u.pn * 256 + wc * 32 + 4 * fq;
        {
            const float* gp = gate + (size_t)b * MODW + col0;
            f32x4 gv[2][2];
#pragma unroll
            for (int bj = 0; bj < 2; ++bj)
#pragma unroll
                for (int n = 0; n < 2; ++n) { const f32x4 t = *(const f32x4*)(gp + bj * 128 + n * 16); gv[bj][n] = (t + 1.0f) * coef; }
#pragma unroll
            for (int ai = 0; ai < 2; ++ai)
#pragma unroll
                for (int m = 0; m < 4; ++m) {
                    const size_t off = (size_t)(row0 + ai * 128 + m * 16) * D + col0;
                    float ss = 0.f;
#pragma unroll
                    for (int bj = 0; bj < 2; ++bj)
#pragma unroll
                        for (int n = 0; n < 2; ++n) {
                            const f32x4 x = *(const f32x4*)(base + off + bj * 128 + n * 16);
                            const f32x4 v = x + gv[bj][n] * acc[ai][bj][m][n];
                            acc[ai][bj][m][n] = v;
                            if (mode != 2) *(f32x4*)(out + off + bj * 128 + n * 16) = v;
                            ss += (v.x * v.x + v.y * v.y) + (v.z * v.z + v.w * v.w);
                        }
                    ss += __shfl_xor(ss, 16); ss += __shfl_xor(ss, 32);
                    if (fq == 0) P[(ai * 128 + wr * 64 + m * 16 + fr) * 4 + wc] = ss;
                    asm volatile("" ::: "memory");
                }
        }
        asm volatile("s_waitcnt lgkmcnt(0)" ::: "memory"); __builtin_amdgcn_s_barrier(); asm volatile("" ::: "memory");
        const int row = wid * 32 + (lane & 31);
        if (lane < 32) {
            const float sp = (P[row * 4 + 0] + P[row * 4 + 1]) + (P[row * 4 + 2] + P[row * 4 + 3]);
            __hip_atomic_store(xbuf + ((size_t)(u.pm * 256 + row) * 8 + u.pn), __float_as_uint(sp), __ATOMIC_RELAXED, __HIP_MEMORY_SCOPE_AGENT);
        }
        asm volatile("s_waitcnt vmcnt(0)" ::: "memory");
        if (lane == 0) __hip_atomic_fetch_add(cnt + 64 * u.pm, 1u, __ATOMIC_RELAXED, __HIP_MEMORY_SCOPE_AGENT);
        if (wid == 0) {
            unsigned spins = 0;
            for (;;) {
                if ((unsigned)__builtin_amdgcn_readfirstlane(__hip_atomic_load(cnt + 64 * u.pm, __ATOMIC_RELAXED, __HIP_MEMORY_SCOPE_AGENT)) >= 64u) break;
                if (++spins > (1u << 22)) break;
                __builtin_amdgcn_s_sleep(2);
            }
            __builtin_amdgcn_fence(__ATOMIC_ACQUIRE, "agent");
        }
        asm volatile("s_waitcnt vmcnt(0) lgkmcnt(0)" ::: "memory"); __builtin_amdgcn_s_barrier(); asm volatile("" ::: "memory");
        if (lane < 32) {
            const unsigned* slot = xbuf + (size_t)(u.pm * 256 + row) * 8; float tot = 0.f;
#pragma unroll
            for (int t = 0; t < 8; ++t) tot += __uint_as_float(__hip_atomic_load(slot + t, __ATOMIC_RELAXED, __HIP_MEMORY_SCOPE_AGENT));
            S[row] = 1.0f / sqrtf(tot * (1.0f / D) + 1e-6f);
        }
        asm volatile("s_waitcnt lgkmcnt(0)" ::: "memory"); __builtin_amdgcn_s_barrier(); asm volatile("" ::: "memory");
#pragma unroll
        for (int bj = 0; bj < 2; ++bj)
#pragma unroll
            for (int n = 0; n < 2; ++n) {
                const int col = col0 + bj * 128 + n * 16;
                const f32x4 gg = *(const f32x4*)(g1 + col);
                f32x4 sc = (f32x4){0.f, 0.f, 0.f, 0.f}, sh = sc, gg2 = sc, sc2v = sc, sh2v = sc;
                if (mode != 2) { sc = *(const f32x4*)(sc1 + (size_t)b * bs1 + col) + 1.0f; sh = *(const f32x4*)(sh1 + (size_t)b * bs1 + col); }
                if (mode == 1) { gg2 = *(const f32x4*)(g2 + col); sc2v = *(const f32x4*)(sc2 + (size_t)b * bs2 + col) + 1.0f; sh2v = *(const f32x4*)(sh2 + (size_t)b * bs2 + col); }
#pragma unroll
                for (int ai = 0; ai < 2; ++ai)
#pragma unroll
                    for (int m = 0; m < 4; ++m) {
                        const int r = ai * 128 + wr * 64 + m * 16 + fr;
                        const size_t off = (size_t)(u.pm * 256 + r) * D + col;
                        const f32x4 xn = acc[ai][bj][m][n] * S[r];
                        if (mode == 2) { *(f32x4*)(outf + off) = xn * gg; }
                        else {
                            const f32x4 h = (xn * gg) * sc + sh;
                            u32x2 w; w.x = pg8::cvt_pk_bf16(h.x, h.y); w.y = pg8::cvt_pk_bf16(h.z, h.w);
                            *(u32x2*)(o1 + off) = w;
                            if (mode == 1) { const f32x4 h2 = (xn * gg2) * sc2v + sh2v; u32x2 w2; w2.x = pg8::cvt_pk_bf16(h2.x, h2.y); w2.y = pg8::cvt_pk_bf16(h2.z, h2.w); *(u32x2*)(o2 + off) = w2; }
                        }
                    }
                asm volatile("" ::: "memory");
            }
    }
};

struct Args { const float* in[28]; float* out; unsigned char* ws; };
enum { I_X = 0, I_C, I_POS, I_NORMG, I_WADA, I_BADA, I_WFFIN, I_WFFOUT, I_S5WIN, I_S5ARE, I_S5AIM, I_S5BRE, I_S5BIM, I_S5CRE, I_S5CIM, I_S5D, I_S5LOGDT, I_S5WGLU, I_S5BGLU, I_S5WOUT,
       I_KVG, I_WADAKV, I_BADAKV, I_WKV, I_WQ, I_SINKS, I_WO, I_FING };

__device__ __forceinline__ void xpose_item(const float* W, int K, int N, bf16_t* WT, int mode, int ropeN, LAS float* scr, int item, int lane) {
    const int nblk = N / 32, kb = item / nblk, nb = item % nblk, k0 = 128 * kb, n0 = 32 * nb;
    int drow = n0;
    if (mode == 1) { const int which = n0 / FF, j = n0 % FF; drow = 256 * (j / 128) + 128 * which + (j % 128); }
    else if (mode == 2 && n0 < ropeN) { const int head = n0 / 64, half = (n0 % 64) / 32; drow = 256 * (head / 4) + 128 * half + 32 * (head % 4); }
    const float* src = W + (size_t)(k0 + (lane >> 5)) * N + n0 + (lane & 31);
    float tv[64];
#pragma unroll
    for (int i = 0; i < 64; ++i) tv[i] = __builtin_nontemporal_load(src + (size_t)(2 * i) * N);
#pragma unroll
    for (int i = 0; i < 64; ++i) scr[(2 * i + (lane >> 5)) * 33 + (lane & 31)] = tv[i];
    asm volatile("s_waitcnt lgkmcnt(0)" ::: "memory");
    const int c = lane & 15;
#pragma unroll
    for (int j = 0; j < 8; ++j) { const int n = (lane >> 4) + 4 * j; const LAS float* s = scr + (8 * c) * 33 + n;
        u32x4 o; o.x = pg8::cvt_pk_bf16(s[0 * 33], s[1 * 33]); o.y = pg8::cvt_pk_bf16(s[2 * 33], s[3 * 33]); o.z = pg8::cvt_pk_bf16(s[4 * 33], s[5 * 33]); o.w = pg8::cvt_pk_bf16(s[6 * 33], s[7 * 33]);
        __builtin_nontemporal_store(o, (u32x4*)(WT + (size_t)(drow + n) * K + k0 + 8 * c)); }
    asm volatile("s_waitcnt lgkmcnt(0)" ::: "memory");
}

__device__ __forceinline__ void gemv_item(const float* W, int N, const float* bias, float* out, int chunk, const LAS f32x4* cact, LAS float* red, int tid, int wave, int lane, unsigned* flag = nullptr) {
    const float* wp = W + (size_t)(256 * wave) * N + 128 * chunk + 2 * lane;
    float a00 = 0.f, a01 = 0.f, a10 = 0.f, a11 = 0.f, a20 = 0.f, a21 = 0.f, a30 = 0.f, a31 = 0.f;
    for (int k = 0; k < 256; k += 16) {
        f32x2 w[16];
#pragma unroll
        for (int uu = 0; uu < 16; ++uu) w[uu] = __builtin_nontemporal_load((const f32x2*)(wp + (size_t)(k + uu) * N));
#pragma unroll
        for (int uu = 0; uu < 16; ++uu) { const f32x4 c = cact[256 * wave + k + uu];
            a00 += c.x * w[uu].x; a01 += c.x * w[uu].y; a10 += c.y * w[uu].x; a11 += c.y * w[uu].y; a20 += c.z * w[uu].x; a21 += c.z * w[uu].y; a30 += c.w * w[uu].x; a31 += c.w * w[uu].y; }
    }
    LAS float* r = red + (wave * 64 + lane) * 8;
    r[0] = a00; r[1] = a01; r[2] = a10; r[3] = a11; r[4] = a20; r[5] = a21; r[6] = a30; r[7] = a31;
    __syncthreads();
    { const int b = tid >> 7, col = tid & 127, l2 = col >> 1, j = col & 1; float s = bias[128 * chunk + col];
#pragma unroll
      for (int w2 = 0; w2 < 8; ++w2) s += red[(w2 * 64 + l2) * 8 + b * 2 + j];
      __hip_atomic_store(out + (size_t)b * N + 128 * chunk + col, s, __ATOMIC_RELAXED, __HIP_MEMORY_SCOPE_AGENT); }
    asm volatile("s_waitcnt vmcnt(0)" ::: "memory");
    __syncthreads();
    if (flag && tid == 0) __hip_atomic_fetch_add(flag, 1u, __ATOMIC_RELAXED, __HIP_MEMORY_SCOPE_AGENT);
}

template <int MODE  >
__device__ __forceinline__ void norm_phase(const float* x, const float* g1, const float* sh1, const float* sc1, int bstride1, bf16_t* out1,
                                           const float* g2, const float* sh2, const float* sc2, int bstride2, bf16_t* out2, float* outf, int wave, int lane) {
    const int gw = blockIdx.x * NWAVES + wave, NGW = gridDim.x * NWAVES;
    for (int row = gw; row < M; row += NGW) {
        const int b = row >> 11;
        const f32x4* xr = (const f32x4*)(x + (size_t)row * D) + lane;
        f32x4 v[8]; float s = 0.f;
#pragma unroll
        for (int j = 0; j < 8; ++j) { v[j] = xr[64 * j]; s += (v[j].x * v[j].x + v[j].y * v[j].y) + (v[j].z * v[j].z + v[j].w * v[j].w); }
        const float rstd = 1.0f / sqrtf(wave_sum(s) * (1.0f / D) + 1e-6f);
#pragma unroll
        for (int j = 0; j < 8; ++j) {
            const int col = 4 * (lane + 64 * j);
            const f32x4 gg = *(const f32x4*)(g1 + col);
            const f32x4 xn = v[j] * rstd;
            if (MODE == 2) { *(f32x4*)(outf + (size_t)row * D + col) = xn * gg; }
            else {
                const f32x4 sc = *(const f32x4*)(sc1 + (size_t)b * bstride1 + col), sh = *(const f32x4*)(sh1 + (size_t)b * bstride1 + col);
                const f32x4 h = (xn * gg) * (sc + 1.0f) + sh;
                u32x2 w; w.x = pg8::cvt_pk_bf16(h.x, h.y); w.y = pg8::cvt_pk_bf16(h.z, h.w);
                *(u32x2*)(out1 + (size_t)row * D + col) = w;
                if (MODE == 1) {
                    const f32x4 gg2 = *(const f32x4*)(g2 + col), sc2v = *(const f32x4*)(sc2 + (size_t)b * bstride2 + col), sh2v = *(const f32x4*)(sh2 + (size_t)b * bstride2 + col);
                    const f32x4 h2 = (xn * gg2) * (sc2v + 1.0f) + sh2v;
                    u32x2 w2; w2.x = pg8::cvt_pk_bf16(h2.x, h2.y); w2.y = pg8::cvt_pk_bf16(h2.z, h2.w);
                    *(u32x2*)(out2 + (size_t)row * D + col) = w2;
                }
            }
        }
    }
}

__device__ __forceinline__ void norm1_phase(const float* x, const float* g1, const float* sh1, const float* sc1, int bstride1, bf16_t* out1, int wave, int lane) {
    const int gw = blockIdx.x * NWAVES + wave, NGW = gridDim.x * NWAVES;
    for (int rowb = gw; rowb < M; rowb += 4 * NGW) {
        f32x4 v[4][8];
#pragma unroll
        for (int r = 0; r < 4; ++r) { const int row = rowb + r * NGW; const f32x4* xr = (const f32x4*)(x + (size_t)(row < M ? row : rowb) * D) + lane;
#pragma unroll
            for (int j = 0; j < 8; ++j) v[r][j] = __builtin_nontemporal_load(xr + 64 * j); }
#pragma unroll
        for (int r = 0; r < 4; ++r) {
            const int row = rowb + r * NGW; if (row >= M) break;
            const int b = row >> 11;
            float s = 0.f;
#pragma unroll
            for (int j = 0; j < 8; ++j) s += (v[r][j].x * v[r][j].x + v[r][j].y * v[r][j].y) + (v[r][j].z * v[r][j].z + v[r][j].w * v[r][j].w);
            const float rstd = 1.0f / sqrtf(wave_sum(s) * (1.0f / D) + 1e-6f);
#pragma unroll
            for (int j = 0; j < 8; ++j) {
                const int col = 4 * (lane + 64 * j);
                const f32x4 gg = *(const f32x4*)(g1 + col);
                const f32x4 sc = *(const f32x4*)(sc1 + (size_t)b * bstride1 + col), sh = *(const f32x4*)(sh1 + (size_t)b * bstride1 + col);
                const f32x4 h = ((v[r][j] * rstd) * gg) * (sc + 1.0f) + sh;
                u32x2 w; w.x = pg8::cvt_pk_bf16(h.x, h.y); w.y = pg8::cvt_pk_bf16(h.z, h.w);
                *(u32x2*)(out1 + (size_t)row * D + col) = w;
            }
        }
    }
}

typedef float f32x16 __attribute__((ext_vector_type(16)));
__device__ __forceinline__ f32x2 cfma(f32x2 a, f32x2 b, f32x2 c) { return (f32x2){a.x * b.x - a.y * b.y + c.x, a.x * b.y + a.y * b.x + c.y}; }
__device__ __forceinline__ void s5_scan_phase(LAS unsigned char* lds, const bf16_t* Vb, bf16_t* Yg, const f32x2* LAM, const f32x2* BBAR,
                                              const float* c_re, const float* c_im, const float* dskip, int tid, int wave, int lane) {
    const int half = lane >> 5, p32 = lane & 31, t16 = lane & 15, kg = lane >> 4;
    LAS unsigned char* img = lds + wave * 8704;
    LAS f32x2* Ech = (LAS f32x2*)(lds + 8 * 8704);
    for (int sp = blockIdx.x; sp < (BATCH * NG) / 2; sp += gridDim.x) {
        const int sq = wave >> 2, chunk = wave & 3, seq = 2 * sp + sq, b = seq >> 7, g = seq & 127;
        const size_t row0 = (size_t)b * SEQ + (size_t)chunk * 512;
        bf16x8 bfr[4];
        f32x2 lam1[2], lam2[2], lam3[2], lam4[2];
#pragma unroll
        for (int pb = 0; pb < 2; ++pb) {
            const f32x4* bp = (const f32x4*)(BBAR + ((size_t)(g * 64 + 32 * pb + p32)) * 16 + 8 * half);
            const f32x4 t0 = bp[0], t1 = bp[1], t2 = bp[2], t3 = bp[3];
            u32x4 wr_, wi_;
            wr_.x = pg8::cvt_pk_bf16(t0.x, t0.z); wr_.y = pg8::cvt_pk_bf16(t1.x, t1.z); wr_.z = pg8::cvt_pk_bf16(t2.x, t2.z); wr_.w = pg8::cvt_pk_bf16(t3.x, t3.z);
            wi_.x = pg8::cvt_pk_bf16(t0.y, t0.w); wi_.y = pg8::cvt_pk_bf16(t1.y, t1.w); wi_.z = pg8::cvt_pk_bf16(t2.y, t2.w); wi_.w = pg8::cvt_pk_bf16(t3.y, t3.w);
            bfr[2 * pb] = __builtin_bit_cast(bf16x8, wr_); bfr[2 * pb + 1] = __builtin_bit_cast(bf16x8, wi_);
            lam1[pb] = LAM[g * 64 + 32 * pb + p32]; lam2[pb] = cmul(lam1[pb], lam1[pb]); lam3[pb] = cmul(lam2[pb], lam1[pb]); lam4[pb] = cmul(lam2[pb], lam2[pb]);
        }
        bf16x8 cfr[4];
#pragma unroll
        for (int kb = 0; kb < 4; ++kb) {
            const size_t co = ((size_t)g * 16 + t16) * 64 + 16 * kb + 4 * kg;
            const f32x4 cr = *(const f32x4*)(c_re + co), ci = *(const f32x4*)(c_im + co);
            u32x4 w; w.x = pg8::cvt_pk_bf16(cr.x, -ci.x); w.y = pg8::cvt_pk_bf16(cr.y, -ci.y); w.z = pg8::cvt_pk_bf16(cr.z, -ci.z); w.w = pg8::cvt_pk_bf16(cr.w, -ci.w);
            cfr[kb] = __builtin_bit_cast(bf16x8, w);
        }
        bf16x8 dfr;
        { const unsigned db = f2bf(dskip[g * 16 + t16]); u32x4 w;
          const int e0 = t16 - 8 * kg;
          w.x = (kg < 2 && e0 == 0) ? db : ((kg < 2 && e0 == 1) ? (db << 16) : 0u);
          w.y = (kg < 2 && e0 == 2) ? db : ((kg < 2 && e0 == 3) ? (db << 16) : 0u);
          w.z = (kg < 2 && e0 == 4) ? db : ((kg < 2 && e0 == 5) ? (db << 16) : 0u);
          w.w = (kg < 2 && e0 == 6) ? db : ((kg < 2 && e0 == 7) ? (db << 16) : 0u);
          dfr = __builtin_bit_cast(bf16x8, w); }
        f32x2 cin[2]; cin[0] = (f32x2){0.f, 0.f}; cin[1] = (f32x2){0.f, 0.f};
        const bf16_t* vA = Vb + (row0 + (8 * (p32 & 3) + 4 * ((p32 >> 2) & 1) + (p32 >> 3))) * D + g * 16 + 8 * half;
        const bf16_t* vS = Vb + (row0 + t16) * D + g * 16 + 8 * (kg & 1);
        for (int pass = 0; pass < 2; ++pass) {
            f32x2 c[2]; c[0] = cin[0]; c[1] = cin[1];
            bf16x8 vnext = *(const bf16x8*)vA;
            bf16x8 snext0 = (bf16x8){0, 0, 0, 0, 0, 0, 0, 0}, snext1 = snext0;
            if (pass == 1 && kg < 2) { snext0 = *(const bf16x8*)vS; snext1 = *(const bf16x8*)(vS + (size_t)16 * D); }
            for (int blk = 0; blk < 16; ++blk) {
                const bf16x8 vcur = vnext, sk0 = snext0, sk1 = snext1;
                if (blk + 1 < 16) {
                    vnext = *(const bf16x8*)(vA + (size_t)(blk + 1) * 32 * D);
                    if (pass == 1 && kg < 2) { snext0 = *(const bf16x8*)(vS + (size_t)((blk + 1) * 32) * D); snext1 = *(const bf16x8*)(vS + (size_t)((blk + 1) * 32 + 16) * D); }
                }
#pragma unroll
                for (int pb = 0; pb < 2; ++pb) {
                    f32x16 re, im;
                    { f32x16 z;
#pragma unroll
                      for (int i = 0; i < 16; ++i) z[i] = 0.f;
                      re = __builtin_amdgcn_mfma_f32_32x32x16_bf16(vcur, bfr[2 * pb], z, 0, 0, 0);
                      im = __builtin_amdgcn_mfma_f32_32x32x16_bf16(vcur, bfr[2 * pb + 1], z, 0, 0, 0); }
                    const f32x2 l1 = lam1[pb], l2 = lam2[pb], l3 = lam3[pb], l4 = lam4[pb];
                    f32x2 R[8], I[8];
#pragma unroll
                    for (int q = 0; q < 8; ++q) { R[q] = (f32x2){re[2 * q], re[2 * q + 1]}; I[q] = (f32x2){im[2 * q], im[2 * q + 1]}; }
#pragma unroll
                    for (int j = 1; j < 4; ++j)
#pragma unroll
                        for (int u = 0; u < 2; ++u) {
                            const f32x2 rp = R[2 * (j - 1) + u], ip = I[2 * (j - 1) + u];
                            R[2 * j + u] = (R[2 * j + u] + rp * l1.x) - ip * l1.y;
                            I[2 * j + u] = (I[2 * j + u] + ip * l1.x) + rp * l1.y;
                        }
                    f32x2 e[4], o[4];
#pragma unroll
                    for (int k = 0; k < 4; ++k) {
                        const float ex = R[6 + (k >> 1)][k & 1], ey = I[6 + (k >> 1)][k & 1];
                        const auto sx = __builtin_amdgcn_permlane32_swap(__float_as_uint(ex), __float_as_uint(ex), false, false);
                        const auto sy = __builtin_amdgcn_permlane32_swap(__float_as_uint(ey), __float_as_uint(ey), false, false);
                        e[k] = (f32x2){__uint_as_float(sx[0]), __uint_as_float(sy[0])}; o[k] = (f32x2){__uint_as_float(sx[1]), __uint_as_float(sy[1])};
                    }
                    f32x2 cc = c[pb], mc[4];
#pragma unroll
                    for (int k = 0; k < 4; ++k) {
                        const f32x2 eh0 = e[k], eh1 = o[k];
                        const f32x2 c0 = cc; cc = cfma(l4, cc, eh0);
                        const f32x2 c1 = cc; cc = cfma(l4, cc, eh1);
                        mc[k] = half ? c1 : c0;
                    }
                    c[pb] = cc;
                    if (pass == 1) {
#pragma unroll
                        for (int u = 0; u < 2; ++u) {
                            const f32x2 mr = (f32x2){mc[2 * u].x, mc[2 * u + 1].x}, mi = (f32x2){mc[2 * u].y, mc[2 * u + 1].y};
                            R[0 + u] = (R[0 + u] + mr * l1.x) - mi * l1.y; I[0 + u] = (I[0 + u] + mi * l1.x) + mr * l1.y;
                            R[2 + u] = (R[2 + u] + mr * l2.x) - mi * l2.y; I[2 + u] = (I[2 + u] + mi * l2.x) + mr * l2.y;
                            R[4 + u] = (R[4 + u] + mr * l3.x) - mi * l3.y; I[4 + u] = (I[4 + u] + mi * l3.x) + mr * l3.y;
                            R[6 + u] = (R[6 + u] + mr * l4.x) - mi * l4.y; I[6 + u] = (I[6 + u] + mi * l4.x) + mr * l4.y;
                        }
#pragma unroll
                        for (int i = 0; i < 16; ++i) {
                            const int t = 8 * (i & 3) + 4 * half + (i >> 2);
                            *(LAS unsigned*)(img + t * 272 + 128 * pb + 4 * p32) = pg8::cvt_pk_bf16(R[i >> 1][i & 1], I[i >> 1][i & 1]);
                        }
                    }
                }
                asm volatile("" : "+v"(vnext), "+v"(snext0), "+v"(snext1));
                if (pass == 1) {
#pragma unroll
                    for (int tb = 0; tb < 2; ++tb) {
                        f32x4 y = (f32x4){0.f, 0.f, 0.f, 0.f};
#pragma unroll
                        for (int kb = 0; kb < 4; ++kb) {
                            const bf16x8 sf = *(const LAS bf16x8*)(img + (16 * tb + t16) * 272 + (32 * kb + 8 * kg) * 2);
                            y = __builtin_amdgcn_mfma_f32_16x16x32_bf16(cfr[kb], sf, y, 0, 0, 0);
                        }
                        y = __builtin_amdgcn_mfma_f32_16x16x32_bf16(dfr, tb ? sk1 : sk0, y, 0, 0, 0);
                        u32x2 w; w.x = pg8::cvt_pk_bf16(gelu_tanh(y.x), gelu_tanh(y.y)); w.y = pg8::cvt_pk_bf16(gelu_tanh(y.z), gelu_tanh(y.w));
                        *(u32x2*)(Yg + (row0 + (size_t)(blk * 32 + 16 * tb + t16)) * D + g * 16 + 4 * kg) = w;
                    }
                }
            }
            if (pass == 0) {
                if (lane < 32) { Ech[((sq * 4 + chunk) * 2 + 0) * 32 + p32] = c[0]; Ech[((sq * 4 + chunk) * 2 + 1) * 32 + p32] = c[1]; }
                __syncthreads();
#pragma unroll
                for (int pb = 0; pb < 2; ++pb) {
                    f32x2 lp = lam4[pb];
#pragma unroll
                    for (int q = 0; q < 7; ++q) lp = cmul(lp, lp);
                    f32x2 ci_ = (f32x2){0.f, 0.f};
                    for (int cc = 0; cc < chunk; ++cc) ci_ = cfma(lp, ci_, Ech[((sq * 4 + cc) * 2 + pb) * 32 + p32]);
                    cin[pb] = ci_;
                }
            }
        }
        __syncthreads();
    }
}

__device__ __forceinline__ void attn_phase(LAS unsigned char* lds, const bf16_t* Q, const bf16_t* Kb, const bf16_t* Vb, bf16_t* O, const float* sinks, int tid, int wave, int lane) {
    constexpr int KS = 144, VS = 528;
    LAS unsigned char* Kl = lds;
    LAS unsigned char* Vt = lds + 256 * KS;
    const int q16 = lane & 15, g = lane >> 4;
    for (int unit0 = blockIdx.x; unit0 < BATCH * 16 * NKVH; unit0 += gridDim.x) {
        const int xq = unit0 & 7, jq = unit0 >> 3;
        const int unit = (gridDim.x == 256) ? ((xq >> 1) * 64 + (8 * (xq & 1) + (jq >> 2)) * 4 + (jq & 3)) : unit0;
        const int kvh = unit & 3, nb = (unit >> 2) & 15, b = unit >> 6;
        for (int e = tid; e < 2048; e += NTHR) {
            const int key = e >> 3, part = e & 7, pos = (nb - 1) * 128 + key;
            u32x4 kv = (u32x4){0u, 0u, 0u, 0u}, vv = (u32x4){0u, 0u, 0u, 0u};
            if (pos >= 0) { const size_t off = ((size_t)b * SEQ + pos) * KVW + kvh * 64 + part * 8; kv = *(const u32x4*)(Kb + off); vv = *(const u32x4*)(Vb + off); }
            *(LAS u32x4*)(Kl + key * KS + part * 16) = kv;
            const int kb = key >> 5, kk = key & 31;
            const int slot = 32 * kb + ((kk & 16) ? (8 * ((kk - 16) >> 2) + 4 + (kk & 3)) : (8 * (kk >> 2) + (kk & 3)));
            LAS unsigned short* vp = (LAS unsigned short*)(Vt + (part * 8) * VS + slot * 2);
            vp[0 * (VS / 2)] = (unsigned short)(vv.x & 0xffffu); vp[1 * (VS / 2)] = (unsigned short)(vv.x >> 16);
            vp[2 * (VS / 2)] = (unsigned short)(vv.y & 0xffffu); vp[3 * (VS / 2)] = (unsigned short)(vv.y >> 16);
            vp[4 * (VS / 2)] = (unsigned short)(vv.z & 0xffffu); vp[5 * (VS / 2)] = (unsigned short)(vv.z >> 16);
            vp[6 * (VS / 2)] = (unsigned short)(vv.w & 0xffffu); vp[7 * (VS / 2)] = (unsigned short)(vv.w >> 16);
        }
        __syncthreads();
        const int hq = kvh * 8 + wave; const float sink2 = sinks[hq] * 1.4426950408889634f;
        const size_t rowbase = (size_t)b * SEQ + nb * 128;
        bf16x8 qfa[8], qfb[8];
#pragma unroll
        for (int qs = 0; qs < 8; ++qs) { const size_t qrow = rowbase + 16 * qs + q16; qfa[qs] = *(const bf16x8*)(Q + qrow * D + hq * 64 + 8 * g); qfb[qs] = *(const bf16x8*)(Q + qrow * D + hq * 64 + 32 + 8 * g); }
#pragma unroll
        for (int qs = 0; qs < 8; ++qs) {
            const bf16x8 qf0 = qfa[qs], qf1 = qfb[qs];
            const int kb0 = 2 * (qs >> 1);
            f32x4 sc[10];
#pragma unroll
            for (int kb = 0; kb < 10; ++kb) {
                const LAS unsigned char* kp = Kl + (16 * (kb0 + kb) + q16) * KS + g * 16;
                const bf16x8 k0 = *(const LAS bf16x8*)kp, k1 = *(const LAS bf16x8*)(kp + 64);
                f32x4 a = (f32x4){0.f, 0.f, 0.f, 0.f};
                a = __builtin_amdgcn_mfma_f32_16x16x32_bf16(k0, qf0, a, 0, 0, 0);
                a = __builtin_amdgcn_mfma_f32_16x16x32_bf16(k1, qf1, a, 0, 0, 0);
                sc[kb] = a;
            }
            const int L0 = 16 * (qs - kb0) + q16 - 4 * g;
            const int L = (nb == 0) ? max(L0, 127 - 16 * kb0 - 4 * g) : L0;
            float mx = sink2;
#pragma unroll
            for (int kb = 0; kb < 10; ++kb)
#pragma unroll
                for (int i = 0; i < 4; ++i) {
                    const int c = 16 * kb + i;
                    bool valid = c > L;
                    if (kb >= 7) valid = valid && (c <= L0 + 128);
                    const float sv = valid ? sc[kb][i] : -__builtin_inff();
                    sc[kb][i] = sv; mx = fmaxf(mx, sv);
                }
            mx = fmaxf(mx, __shfl_xor(mx, 16)); mx = fmaxf(mx, __shfl_xor(mx, 32));
            float sum = 0.f;
#pragma unroll
            for (int kb = 0; kb < 10; ++kb)
#pragma unroll
                for (int i = 0; i < 4; ++i) { const float pv = __builtin_amdgcn_exp2f(sc[kb][i] - mx); sc[kb][i] = pv; sum += pv; }
            sum += __shfl_xor(sum, 16); sum += __shfl_xor(sum, 32);
            sum += __builtin_amdgcn_exp2f(sink2 - mx);
            const float inv = 1.0f / sum;
            f32x4 o[4];
#pragma unroll
            for (int db = 0; db < 4; ++db) o[db] = (f32x4){0.f, 0.f, 0.f, 0.f};
#pragma unroll
            for (int j = 0; j < 5; ++j) {
                u32x4 pw;
                pw.x = pg8::cvt_pk_bf16(sc[2 * j][0], sc[2 * j][1]); pw.y = pg8::cvt_pk_bf16(sc[2 * j][2], sc[2 * j][3]);
                pw.z = pg8::cvt_pk_bf16(sc[2 * j + 1][0], sc[2 * j + 1][1]); pw.w = pg8::cvt_pk_bf16(sc[2 * j + 1][2], sc[2 * j + 1][3]);
                const bf16x8 pa = __builtin_bit_cast(bf16x8, pw);
#pragma unroll
                for (int db = 0; db < 4; ++db) {
                    const bf16x8 vf = *(const LAS bf16x8*)(Vt + (16 * db + q16) * VS + (32 * ((qs >> 1) + j) + 8 * g) * 2);
                    o[db] = __builtin_amdgcn_mfma_f32_16x16x32_bf16(vf, pa, o[db], 0, 0, 0);
                }
            }
#pragma unroll
            for (int db = 0; db < 4; ++db) {
                const f32x4 ov = o[db] * inv;
                u32x2 w; w.x = pg8::cvt_pk_bf16(ov.x, ov.y); w.y = pg8::cvt_pk_bf16(ov.z, ov.w);
                *(u32x2*)(O + (rowbase + 16 * qs + q16) * D + hq * 64 + 16 * db + 4 * g) = w;
            }
        }
        __syncthreads();
    }
}

#define GEMM_PHASE(EpiT, E, Aptr, Bptr, Nn, Kk) do { pg8::Gemm g_{(const bf16_t*)(Aptr), (const bf16_t*)(Bptr), M, (Nn), (Kk)}; pg8::StaticOrder S_; S_.init(M, (Nn), (int)gridDim.x, (int)blockIdx.x); \
    pg8::gemm_phase<EpiT, pg8::StaticOrder, true, true>(ldsb, g_, S_, E); } while (0)

#define XB_TMO      128
#define XB_XCNT(j)  (256  + 64 * (j))
#define XB_XSUB(j)  (1280 + 64 * (j))
#define XB_XGEN(j)  (2304 + 64 * (j))
#define XB_TOP      3328
#define XB_TOPGEN   3392
#define XCD_BAR_WORDS 3456
#define XB_SPIN_CAP (1u << 18)

__device__ __forceinline__ unsigned xb_ld(unsigned* p)              { return __hip_atomic_load(p, __ATOMIC_RELAXED, __HIP_MEMORY_SCOPE_AGENT); }
__device__ __forceinline__ unsigned xb_add(unsigned* p, unsigned v) { return __hip_atomic_fetch_add(p, v, __ATOMIC_RELAXED, __HIP_MEMORY_SCOPE_AGENT); }
__device__ __forceinline__ unsigned xb_xcc_id() { return (unsigned)__builtin_amdgcn_s_getreg((3 << 11) | 20) & 0xFu; }
#define XB_SPIN(cond, bar) do { unsigned _sp = 0; while (cond) { __builtin_amdgcn_s_sleep(1); \
    if ((++_sp & 255u) == 0u) { if (xb_ld(&(bar)[XB_TMO])) break; if (_sp > XB_SPIN_CAP) { atomicAdd(&(bar)[XB_TMO], 1u); break; } } } } while (0)

struct XcdBarrier {
    unsigned* bar; unsigned x;
    volatile LAS unsigned* st;
};

__device__ __forceinline__ XcdBarrier xcd_barrier_post(unsigned* bar, volatile LAS unsigned* st) {
    XcdBarrier b; b.bar = bar; b.x = xb_xcc_id(); b.st = st;
    if (threadIdx.x == 0) (void)xb_add(&bar[XB_XCNT(b.x)], 1u);
    return b;
}
__device__ __forceinline__ void xcd_barrier_complete(unsigned* bar, unsigned x, unsigned& nloc, unsigned& nx) {
    const unsigned G = gridDim.x * gridDim.y * gridDim.z;
    unsigned sum, cnt, mine, sp = 0u;
    for (;;) {
        sum = 0u; cnt = 0u; mine = 0u;
#pragma unroll
        for (unsigned j = 0; j < 16; ++j) { const unsigned c = xb_ld(&bar[XB_XCNT(j)]); sum += c; cnt += (c > 0u) ? 1u : 0u; mine = (j == x) ? c : mine; }
        if (sum == G) break;
        __builtin_amdgcn_s_sleep(1);
        if ((++sp & 255u) == 0u) { if (xb_ld(&bar[XB_TMO])) break; if (sp > XB_SPIN_CAP) { atomicAdd(&bar[XB_TMO], 1u); break; } }
    }
    nloc = mine > 0u ? mine : 1u; nx = cnt > 0u ? cnt : 1u;
}

__device__ __forceinline__ void xcd_barrier(const XcdBarrier& b) {
    asm volatile("s_waitcnt vmcnt(0)" ::: "memory");
    __syncthreads();
    if (threadIdx.x == 0) {
        unsigned* bar = b.bar;
        __builtin_amdgcn_s_waitcnt(0);
        unsigned nloc = b.st[0], nx = b.st[1];
        if (nloc == 0u) { xcd_barrier_complete(bar, b.x, nloc, nx); b.st[0] = nloc; b.st[1] = nx; }
        const unsigned old = xb_add(&bar[XB_XSUB(b.x)], 1u);
        const unsigned gen = old / nloc;
        if (old + 1u == (gen + 1u) * nloc) {
            __builtin_amdgcn_fence(__ATOMIC_RELEASE, "agent");
            asm volatile("s_waitcnt vmcnt(0)" ::: "memory");
            const unsigned og = xb_add(&bar[XB_TOP], 1u);
            const unsigned tg = og / nx;
            if (og + 1u == (tg + 1u) * nx) xb_add(&bar[XB_TOPGEN], 1u);
            else XB_SPIN(xb_ld(&bar[XB_TOPGEN]) == tg, bar);
            __builtin_amdgcn_fence(__ATOMIC_ACQUIRE, "agent");
            xb_add(&bar[XB_XGEN(b.x)], 1u);
            asm volatile("s_waitcnt vmcnt(0)" ::: "memory");
        } else {
            XB_SPIN(xb_ld(&bar[XB_XGEN(b.x)]) == gen, bar);
            __builtin_amdgcn_fence(__ATOMIC_ACQUIRE, "agent");
            asm volatile("s_waitcnt vmcnt(0)" ::: "memory");
        }
    }
    __syncthreads();
}

typedef const Args __attribute__((address_space(4)))* KArgs;
#define GETARGS() KArgs ka = (KArgs)__builtin_amdgcn_kernarg_segment_ptr(); asm volatile("" : "+s"(ka)); unsigned char* ws = ka->ws
#define LAUNDER_TID() int tid = threadIdx.x; asm volatile("" : "+v"(tid)); const int lane = tid & 63, wave = __builtin_amdgcn_readfirstlane(tid >> 6)
#define WSP(T, off) ((T*)(ws + (off)))
#ifndef SYNC_REPS
#define SYNC_REPS 1
#endif
#define GSYNC() do { for (int r_ = 0; r_ < SYNC_REPS; ++r_) xcd_barrier(xbar); } while (0)
#ifndef REP_P0
#define REP_P0 1
#define REP_NORM 1
#define REP_SCAN 1
#define REP_ATTN 1
#endif
#define XPOSE_MATS(mask, active, gw_, NGW_) do { \
    for (int mv = 0; mv < 22; ++mv) { if (!(((mask) >> mv) & 1u)) continue; \
        const int mi = mv < 14 ? mv : ((mv - 14) >> 1);        \
        const float* W; bf16_t* WT; int K, N, mode = 0, ropeN = 0; \
        if (mi < 4) { W = ka->in[I_WFFIN] + (size_t)mi * D * 2 * FF; WT = WSP(bf16_t, WS_WFFIN) + (size_t)mi * D * 2 * FF; K = D; N = 2 * FF; mode = 1; } \
        else if (mi < 8) { W = ka->in[I_WFFOUT] + (size_t)(mi - 4) * FF * D; WT = WSP(bf16_t, WS_WFFOUT) + (size_t)(mi - 4) * FF * D; K = FF; N = D; } \
        else if (mi == 8) { W = ka->in[I_S5WIN]; WT = WSP(bf16_t, WS_WS5IN); K = D; N = D; } \
        else if (mi == 9) { W = ka->in[I_S5WGLU]; WT = WSP(bf16_t, WS_WS5GLU); K = D; N = D; } \
        else if (mi == 10) { W = ka->in[I_S5WOUT]; WT = WSP(bf16_t, WS_WS5OUT); K = D; N = D; } \
        else if (mi == 11) { W = ka->in[I_WQ]; WT = WSP(bf16_t, WS_WQ); K = D; N = D; mode = 2; ropeN = D; } \
        else if (mi == 12) { W = ka->in[I_WO]; WT = WSP(bf16_t, WS_WO); K = D; N = D; } \
        else { W = ka->in[I_WKV]; WT = WSP(bf16_t, WS_WKV); K = D; N = 2 * KVW; mode = 2; ropeN = KVW; } \
        const int nitems = (K / 128) * (N / 32); \
        const int lo_ = (mv >= 14 && ((mv - 14) & 1)) ? nitems / 2 : 0, hi_ = (mv >= 14 && !((mv - 14) & 1)) ? nitems / 2 : nitems; \
        if (active) for (int it = lo_ + (gw_); it < hi_; it += (NGW_)) xpose_item(W, K, N, WT, mode, ropeN, scr, it, lane); \
    } } while (0)
__global__ void __launch_bounds__(NTHR, 2) yoco_fwd(Args args) {
    extern __shared__ __attribute__((aligned(16))) unsigned char lds[];
    LAS unsigned char* ldsb = (LAS unsigned char*)lds;
    cg::grid_group grid = cg::this_grid();
    if (threadIdx.x < 16) ((volatile LAS unsigned*)(ldsb + 147200))[threadIdx.x] = 0u;
    __syncthreads();

    for (int rep_ = 0; rep_ < REP_P0; ++rep_) {
        if (rep_) grid.sync();
        GETARGS(); LAUNDER_TID();
        float* MOD0 = WSP(float, WS_MOD0); float* MODKV = WSP(float, WS_MODKV);
        LAS f32x4* cact = (LAS f32x4*)ldsb;
        LAS float* red = (LAS float*)(ldsb + 32768);
        LAS float* scr = (LAS float*)(ldsb + wave * 16896);
        { const float* cin = ka->in[I_C];
          for (int i = tid; i < BATCH * D; i += NTHR) { const int b = i >> 11, k = i & 2047; const float v = cin[i]; ((LAS float*)cact)[k * 4 + b] = v * fast_sigmoid(v); } }
        __syncthreads();
        for (int it = blockIdx.x; it < 320; it += gridDim.x) {
            if (it < 288) { const int l = it / 144, ch = it % 144; gemv_item(ka->in[I_WADA] + (size_t)l * D * MODW, MODW, ka->in[I_BADA] + (size_t)l * MODW, MOD0 + (size_t)l * (WS_MOD1 / 4), ch, cact, red, tid, wave, lane, it < 32 ? WSP(unsigned, WS_GFLAG) : nullptr); }
            else gemv_item(ka->in[I_WADAKV], 2 * D, ka->in[I_BADAKV], MODKV, it - 288, cact, red, tid, wave, lane);
        }
        if (rep_ == 0) {
            if (wave == 0) { unsigned spins = 0; unsigned* gf = WSP(unsigned, WS_GFLAG);
                while ((unsigned)__builtin_amdgcn_readfirstlane(__hip_atomic_load(gf, __ATOMIC_RELAXED, __HIP_MEMORY_SCOPE_AGENT)) < 32u) { if (++spins > (1u << 22)) break; __builtin_amdgcn_s_sleep(2); }
                __builtin_amdgcn_fence(__ATOMIC_ACQUIRE, "agent"); asm volatile("s_waitcnt vmcnt(0)" ::: "memory"); }
            __syncthreads();
            norm1_phase(ka->in[I_X], ka->in[I_NORMG], MOD0, MOD0 + D, MODW, WSP(bf16_t, WS_XN), wave, lane);
        }
        const bool two = (int)blockIdx.x + (int)gridDim.x < 320;
        const int n2 = 320 - (int)gridDim.x > 0 ? 320 - (int)gridDim.x : 0;
        const int gw = two ? (int)blockIdx.x * 6 + wave : n2 * 6 + ((int)blockIdx.x - n2) * NWAVES + wave, NGW = n2 * 6 + ((int)gridDim.x - n2) * NWAVES;
        XPOSE_MATS(0x00080003u, (!two || wave < 6), gw, NGW);
        if (blockIdx.x == 0) { for (int i = tid; i < 6 * 32 * 64; i += NTHR) WSP(unsigned, WS_CTL)[i] = 0u; for (int i = tid; i < 4096; i += NTHR) WSP(unsigned, WS_BAR)[i] = 0u; }
        const int gt = blockIdx.x * NTHR + tid, NGT = gridDim.x * NTHR;
        { const int* pos = (const int*)ka->in[I_POS]; float* COS = WSP(float, WS_COS); float* SIN = WSP(float, WS_SIN);
          for (int idx = gt; idx < M * 32; idx += NGT) {
            const int row = idx >> 5, j = idx & 31;
            double inv = 1.0; for (int q = 0; q < j; ++q) inv *= 0.74989420933245582730;
            double sn, cs; sincos_d((double)pos[row] * inv, sn, cs);
            COS[idx] = (float)cs; SIN[idx] = (float)sn;
          } }
        { f32x2* LAM = WSP(f32x2, WS_LAM); f32x2* BBAR = WSP(f32x2, WS_BBAR);
          const float* a_re = ka->in[I_S5ARE]; const float* a_im = ka->in[I_S5AIM]; const float* ldt = ka->in[I_S5LOGDT]; const float* bre = ka->in[I_S5BRE]; const float* bim = ka->in[I_S5BIM];
          for (int it2 = gt; it2 < NG * SP * SH; it2 += NGT) {
            const int idx = it2 >> 4, h = it2 & 15, g = idx >> 6;
            const double are = (double)a_re[idx], aim = (double)a_im[idx];
            const double dt = exp_d((double)ldt[g]);
            double sn, cs; sincos_d(aim * dt, sn, cs);
            const double mag = exp_d(are * dt), lbr = mag * cs, lbi = mag * sn;
            if (h == 0) LAM[idx] = (f32x2){(float)lbr, (float)lbi};
            const double nr = lbr - 1.0, ni = lbi, den = 1.0 / (are * are + aim * aim);
            const double cr = (nr * are + ni * aim) * den, ci = (ni * are - nr * aim) * den;
            const double br = (double)bre[it2], bi = (double)bim[it2];
            BBAR[it2] = (f32x2){(float)(cr * br - ci * bi), (float)(cr * bi + ci * br)};
          } }
    }
    grid.sync();
    XcdBarrier xbar;
    { GETARGS(); xbar = xcd_barrier_post(WSP(unsigned, WS_BAR), (volatile LAS unsigned*)(ldsb + 147200) + 8); }

    for (int s = 0; s < 6; ++s) {
        const int layer = s / 3, sub = s % 3;
        if (sub != 1) {
            const int fi = layer * 2 + (sub >> 1);
            if (s == 3) { GETARGS(); EpiRope E{WSP(bf16_t, WS_K), KVW, WSP(bf16_t, WS_VB), KVW, 1, WSP(float, WS_COS), WSP(float, WS_SIN), 1.0f};
                          pg8::Gemm g_{WSP(bf16_t, WS_XN2), WSP(bf16_t, WS_WKV), M, 2 * KVW, D}; pg8::StaticOrder S_; S_.init(M, 2 * KVW, (int)gridDim.x, (int)((blockIdx.x + 128u) & 255u));
                          pg8::gemm_phase<EpiRope, pg8::StaticOrder, true, true>(ldsb, g_, S_, E); }
            { GETARGS(); EpiSwiGLU E{WSP(bf16_t, WS_H)}; GEMM_PHASE(EpiSwiGLU, E, WSP(bf16_t, WS_XN), WSP(bf16_t, WS_WFFIN) + (size_t)fi * D * 2 * FF, 2 * FF, D); }
            if (gridDim.x == 256) {
                const int first = (s == 3) ? 192 : 128;
                const unsigned mask = (s == 0) ? 0x00040710u : ((s == 2) ? 0x2028u : ((s == 3) ? 0x1840u : 0x0080u));
                if ((int)blockIdx.x >= first) { GETARGS(); LAUNDER_TID(); (void)tid;
                    LAS float* scr = (LAS float*)(ldsb + wave * 16896);
                    XPOSE_MATS(mask, true, ((int)blockIdx.x - first) * NWAVES + wave, (256 - first) * NWAVES); }
            }
        } else if (layer == 0) {
            { GETARGS(); EpiRope E{WSP(bf16_t, WS_V), D, WSP(bf16_t, WS_V), D, 0, WSP(float, WS_COS), WSP(float, WS_SIN), 1.0f}; GEMM_PHASE(EpiRope, E, WSP(bf16_t, WS_XN), WSP(bf16_t, WS_WS5IN), D, D); }
            GSYNC();
            for (int rep_ = 0; rep_ < REP_SCAN; ++rep_) { if (rep_) GSYNC(); GETARGS(); LAUNDER_TID();
                s5_scan_phase(ldsb, WSP(bf16_t, WS_V), WSP(bf16_t, WS_Y), WSP(f32x2, WS_LAM), WSP(f32x2, WS_BBAR), ka->in[I_S5CRE], ka->in[I_S5CIM], ka->in[I_S5D], tid, wave, lane); }
            GSYNC();
            { GETARGS(); EpiGLU E{WSP(bf16_t, WS_Y), WSP(bf16_t, WS_Z), ka->in[I_S5BGLU]}; GEMM_PHASE(EpiGLU, E, WSP(bf16_t, WS_Y), WSP(bf16_t, WS_WS5GLU), D, D); }
        } else {
            { GETARGS(); EpiRope E{WSP(bf16_t, WS_Q), D, WSP(bf16_t, WS_Q), D, 8, WSP(float, WS_COS), WSP(float, WS_SIN), 0.125f * 1.4426950408889634f}; GEMM_PHASE(EpiRope, E, WSP(bf16_t, WS_XN), WSP(bf16_t, WS_WQ), D, D); }
            GSYNC();
            for (int rep_ = 0; rep_ < REP_ATTN; ++rep_) { if (rep_) GSYNC(); GETARGS(); LAUNDER_TID();
                attn_phase(ldsb, WSP(bf16_t, WS_Q), WSP(bf16_t, WS_K), WSP(bf16_t, WS_VB), WSP(bf16_t, WS_O), ka->in[I_SINKS], tid, wave, lane); }
        }
        GSYNC();
        {
            GETARGS();
            int sv = s; asm volatile("" : "+s"(sv));
            const int l0 = sv / 3, sb0 = sv % 3, s1 = sv + 1, l1 = s1 / 3, sb1 = s1 % 3;
            const float* MOD0 = WSP(float, WS_MOD0); const float* MODKV = WSP(float, WS_MODKV); float* X = WSP(float, WS_X);
            const float* modl = MOD0 + (size_t)l0 * (WS_MOD1 / 4) + (size_t)sb0 * (3 * D);
            const float* mod1 = MOD0 + (size_t)l1 * (WS_MOD1 / 4) + (size_t)sb1 * (3 * D);
            const bf16_t* Ares; const bf16_t* Bres; int Kres;
            if (sb0 != 1) { Ares = WSP(bf16_t, WS_H); Bres = WSP(bf16_t, WS_WFFOUT) + (size_t)(l0 * 2 + (sb0 >> 1)) * FF * D; Kres = FF; }
            else if (l0 == 0) { Ares = WSP(bf16_t, WS_Z); Bres = WSP(bf16_t, WS_WS5OUT); Kres = D; }
            else { Ares = WSP(bf16_t, WS_O); Bres = WSP(bf16_t, WS_WO); Kres = D; }
            EpiResidNorm E{(sv == 0) ? ka->in[I_X] : (const float*)X, X, modl + 2 * D, sv,
                           ka->in[I_NORMG], ka->in[I_FING], mod1, mod1 + D, MODW, WSP(bf16_t, WS_XN),
                           ka->in[I_KVG], MODKV, MODKV + D, 2 * D, WSP(bf16_t, WS_XN2), ka->out,
                           WSP(unsigned, WS_XBUF) + (size_t)sv * M * 8, WSP(unsigned, WS_CTL) + (size_t)sv * 32 * 64};
            pg8::Gemm g_{Ares, Bres, M, D, Kres}; pg8::StaticOrder S_; S_.init(M, D, (int)gridDim.x, (int)blockIdx.x);
            pg8::gemm_phase<EpiResidNorm, pg8::StaticOrder, false, true>(ldsb, g_, S_, E);
        }
        if (s < 5) GSYNC();
    }
}

extern "C" void kernel_launch(void* const* d_in, const int* in_sizes, int n_in, void* d_out, int out_size, void* d_ws, size_t ws_size, hipStream_t stream) {
    static int grid = 0;
    if (grid == 0) {
        if (n_in != 28 || out_size != M * D || ws_size < WS_END) { fprintf(stderr, "kernel_launch: unexpected problem (n_in %d, out %d, ws %zu)\n", n_in, out_size, ws_size); grid = -1; return; }
        int dev = 0, cus = 0, per_cu = 0;
        hipGetDevice(&dev); hipDeviceGetAttribute(&cus, hipDeviceAttributeMultiprocessorCount, dev);
        if (hipFuncSetAttribute((const void*)yoco_fwd, hipFuncAttributeMaxDynamicSharedMemorySize, LDS_BYTES) != hipSuccess) { fprintf(stderr, "kernel_launch: hipFuncSetAttribute failed\n"); grid = -1; return; }
        if (hipOccupancyMaxActiveBlocksPerMultiprocessor(&per_cu, (const void*)yoco_fwd, NTHR, LDS_BYTES) != hipSuccess || per_cu < 1) { fprintf(stderr, "kernel_launch: occupancy query gave %d\n", per_cu); per_cu = 1; }
        (void)hipGetLastError();
        grid = cus * per_cu;
        if (grid != 256) { fprintf(stderr, "kernel_launch: need exactly 256 co-resident workgroups, got %d\n", grid); if (grid > 256) grid = 256; else { grid = -1; return; } }
    }
    if (grid < 0) return;
    if (hipMemsetAsync((char*)d_ws + WS_GFLAG, 0, 256, stream) != hipSuccess) { fprintf(stderr, "kernel_launch: memset failed\n"); return; }
    Args a{};
    for (int i = 0; i < 28; ++i) a.in[i] = (const float*)d_in[i];
    a.out = (float*)d_out; a.ws = (unsigned char*)d_ws;
    void* kargs[] = {&a};
    hipError_t e = hipLaunchCooperativeKernel((const void*)yoco_fwd, dim3(grid), dim3(NTHR), kargs, LDS_BYTES, stream);
    if (e != hipSuccess) fprintf(stderr, "kernel_launch: cooperative launch failed: %s (grid %d)\n", hipGetErrorString(e), grid);
}
```

```cpp
#include <hip/hip_runtime.h>
#include <hip/hip_cooperative_groups.h>
#include <cstdio>
#include <cstdint>
namespace pg8 {
#define PG8_LAS __attribute__((address_space(3)))
typedef unsigned short bf16_t;
typedef short bf16x8 __attribute__((ext_vector_type(8)));
typedef float f32x4 __attribute__((ext_vector_type(4)));
typedef unsigned u32x4 __attribute__((ext_vector_type(4)));
constexpr int BM = 256, BK = 64, HALF = 128, HTB = HALF * BK * 2  , STAGE_BYTES = 8 * HTB, NXCD = 8, WGM = 4;

__host__ __device__ __forceinline__ int lds_byte(int r, int c) { const int st = (r >> 4) * 2 + (c >> 5), rr = r & 15, cc = c & 31, ob = rr * 64 + cc * 2; return st * 1024 + (ob ^ (((ob >> 9) & 1) << 5)); }
__host__ __device__ __forceinline__ void stage_rc(int b, int& R, int& C) { const int st = b / 1024, sb = b % 1024, swz = sb ^ (((sb >> 9) & 1) << 5); R = (st >> 1) * 16 + swz / 64; C = (st & 1) * 32 + (swz % 64) / 2; }
__host__ __device__ __forceinline__ int perm32(int rho) { const int n = rho >> 4, i = rho & 15; return 8 * (i >> 2) + 4 * n + (i & 3); }

struct Unit { int pm, pn; };
struct Gemm { const bf16_t* A; const bf16_t* Bt; int M, N, K; };

struct StaticOrder {
    int nM, nN, nwg, G, c;
    __host__ __device__ void init(int M, int N, int G_, int c_) { nM = M / BM; nN = N / BM; nwg = nM * nN; G = G_; c = c_; }
    __host__ __device__ bool next(int i, Unit& u) const {
        const long L = (long)i * G + c; if (L >= nwg) return false;
        int wgid = (int)L; { const int q = nwg / NXCD, r = nwg % NXCD, xcd = wgid % NXCD, off = wgid / NXCD; wgid = (xcd < r ? xcd * (q + 1) : r * (q + 1) + (xcd - r) * q) + off; }
        const int nig = WGM * nN, gid = wgid / nig, fm = gid * WGM, gsz = (nM - fm) < WGM ? (nM - fm) : WGM;
        u.pm = fm + ((wgid % nig) % gsz); u.pn = (wgid % nig) / gsz; return true;
    }
    __device__ __forceinline__ void a_ready(const Unit&) const {}
    __device__ __forceinline__ void done(const Unit&) const {}
};

__device__ __forceinline__ unsigned cvt_pk_bf16(float lo, float hi) { unsigned r; asm volatile("v_cvt_pk_bf16_f32 %0, %1, %2" : "=v"(r) : "v"(lo), "v"(hi)); return r; }
typedef float f32x2 __attribute__((ext_vector_type(2)));
template <class Epi, class Sched, bool ALIGN_EPI = false, bool SP2 = false>
__device__ __forceinline__ void gemm_phase(PG8_LAS unsigned char* lds, const Gemm g, const Sched& S, const Epi& E) {
    int tid_ = threadIdx.x; asm volatile("" : "+v"(tid_));
    const int tid = tid_, wid = __builtin_amdgcn_readfirstlane(tid >> 6), lane = tid & 63, wr = wid >> 2, wc = wid & 3, fr = lane & 15, fq = lane >> 4;
    const int K = g.K, nt = K / BK;
    unsigned voffA[2], voffB[2];
#pragma unroll
    for (int i = 0; i < 2; ++i) { int R, C; stage_rc(tid * 16 + i * 8192, R, C); const int Rb = Epi::PERM ? ((R & ~31) + perm32(R & 31)) : R;
        voffA[i] = (unsigned)(R * K + C) * 2u; voffB[i] = (unsigned)(Rb * K + C) * 2u; }
    const size_t kstep = (size_t)(BK * 2);
    const size_t hstep = (size_t)HALF * K * 2;
    const size_t tstep = 2 * hstep;
    const unsigned ldsw = (unsigned)wid * 1024u;
    const int aoff = lds_byte(wr * 64 + fr, fq * 8), boff = lds_byte(wc * 32 + fr, fq * 8);
#define PG8_SA(b, h) (((b) * 2 + (h)) * HTB)
#define PG8_SB(b, h) ((4 + (b) * 2 + (h)) * HTB)
#define PG8_STAGE(bufoff, gbase, voff) do { _Pragma("unroll") for (int _i = 0; _i < 2; ++_i) \
        __builtin_amdgcn_global_load_lds((const unsigned*)((const char*)(gbase) + (voff)[_i]), (PG8_LAS unsigned*)(lds + (bufoff) + ldsw + _i * 8192), 16, 0, 0); } while (0)
#define PG8_LDA(dst, b, h) do { _Pragma("unroll") for (int m = 0; m < 4; ++m) _Pragma("unroll") for (int k = 0; k < 2; ++k) dst[m][k] = *(const PG8_LAS bf16x8*)(lds + PG8_SA(b, h) + aoff + m * 2048 + k * 1024); } while (0)
#define PG8_LDB(dst, b, h) do { _Pragma("unroll") for (int n = 0; n < 2; ++n) _Pragma("unroll") for (int k = 0; k < 2; ++k) dst[n][k] = *(const PG8_LAS bf16x8*)(lds + PG8_SB(b, h) + boff + n * 2048 + k * 1024); } while (0)
#define PG8_MMA(ai, bj, At, Bt) do { __builtin_amdgcn_s_setprio(1); _Pragma("unroll") for (int m = 0; m < 4; ++m) _Pragma("unroll") for (int n = 0; n < 2; ++n) _Pragma("unroll") for (int k = 0; k < 2; ++k) \
        acc[ai][bj][m][n] = __builtin_amdgcn_mfma_f32_16x16x32_bf16(Bt[n][k], At[m][k], acc[ai][bj][m][n], 0, 0, 0); __builtin_amdgcn_s_setprio(0); } while (0)
#define PG8_WAIT_V(n) asm volatile("s_waitcnt vmcnt(" #n ")" ::: "memory")
#define PG8_WAIT_L(n) asm volatile("s_waitcnt lgkmcnt(" #n ")" ::: "memory")
#define PG8_BAR __builtin_amdgcn_s_barrier()
#define PG8_SCHED __builtin_amdgcn_sched_barrier(0)
    Unit cur, nxt; int ui = 0;
    if (!S.next(0, cur)) return;
    f32x4 acc[2][2][4][2];
#pragma unroll
    for (int a = 0; a < 2; ++a)
#pragma unroll
        for (int b = 0; b < 2; ++b)
#pragma unroll
            for (int m = 0; m < 4; ++m)
#pragma unroll
                for (int n = 0; n < 2; ++n) acc[a][b][m][n] = (f32x4){0.f, 0.f, 0.f, 0.f};
    bf16x8 At[4][2], B0[2][2], B1[2][2];
    const char* cA = (const char*)g.A + (size_t)cur.pm * tstep; const char* cB = (const char*)g.Bt + (size_t)cur.pn * tstep;
    S.a_ready(cur);
    if constexpr (SP2) {
        PG8_STAGE(PG8_SB(0, 0), cB, voffB); PG8_STAGE(PG8_SB(0, 1), cB + hstep, voffB); PG8_STAGE(PG8_SA(0, 0), cA, voffA); PG8_STAGE(PG8_SA(0, 1), cA + hstep, voffA);
        if (wr == 1) PG8_BAR;
        PG8_WAIT_V(2); PG8_BAR;
        PG8_STAGE(PG8_SB(1, 0), cB + kstep, voffB); PG8_STAGE(PG8_SA(1, 0), cA + kstep, voffA); PG8_STAGE(PG8_SB(1, 1), cB + hstep + kstep, voffB);
        PG8_WAIT_V(6); PG8_BAR;
    } else {
        PG8_STAGE(PG8_SB(0, 0), cB, voffB); PG8_STAGE(PG8_SA(0, 0), cA, voffA); PG8_STAGE(PG8_SB(0, 1), cB + hstep, voffB); PG8_STAGE(PG8_SA(0, 1), cA + hstep, voffA);
        if (wr == 1) PG8_BAR;
        PG8_WAIT_V(4); PG8_BAR;
        PG8_STAGE(PG8_SB(1, 0), cB + kstep, voffB); PG8_STAGE(PG8_SA(1, 0), cA + kstep, voffA); PG8_STAGE(PG8_SB(1, 1), cB + hstep + kstep, voffB);
        PG8_WAIT_V(6); PG8_BAR;
    }
    for (;;) {
        const bool has_next = S.next(ui + 1, nxt);
        const char* nA = has_next ? (const char*)g.A + (size_t)nxt.pm * tstep : cA; const char* nB = has_next ? (const char*)g.Bt + (size_t)nxt.pn * tstep : cB;
        for (int t = 0; t < nt; t += 2) {
            const bool last = (t == nt - 2);
            const char* a1 = cA + (size_t)(t + 1) * kstep;
            const char* a2 = last ? nA : cA + (size_t)(t + 2) * kstep; const char* b2 = last ? nB : cB + (size_t)(t + 2) * kstep;
            const char* a3 = a2 + kstep; const char* b3 = b2 + kstep;
            if (last && has_next) S.a_ready(nxt);
            if constexpr (SP2) {
            PG8_LDB(B0, 0, 0); PG8_LDB(B1, 0, 1); PG8_SCHED; PG8_LDA(At, 0, 0); PG8_STAGE(PG8_SA(1, 1), a1 + hstep, voffA);
            PG8_WAIT_V(8); PG8_WAIT_L(0); PG8_BAR; PG8_MMA(0, 0, At, B0); PG8_MMA(0, 1, At, B1); PG8_BAR; PG8_SCHED;
            PG8_LDA(At, 0, 1); PG8_STAGE(PG8_SB(0, 0), b2, voffB); PG8_STAGE(PG8_SB(0, 1), b2 + hstep, voffB); PG8_STAGE(PG8_SA(0, 0), a2, voffA);
            PG8_WAIT_V(8); PG8_WAIT_L(0); PG8_BAR; PG8_MMA(1, 0, At, B0); PG8_MMA(1, 1, At, B1); PG8_BAR; PG8_SCHED;
            PG8_LDB(B0, 1, 0); PG8_LDB(B1, 1, 1); PG8_SCHED; PG8_LDA(At, 1, 0); PG8_STAGE(PG8_SA(0, 1), a2 + hstep, voffA);
            PG8_WAIT_V(8); PG8_WAIT_L(0); PG8_BAR; PG8_MMA(0, 0, At, B0); PG8_MMA(0, 1, At, B1); PG8_BAR; PG8_SCHED;
            PG8_LDA(At, 1, 1); PG8_STAGE(PG8_SB(1, 0), b3, voffB); PG8_STAGE(PG8_SB(1, 1), b3 + hstep, voffB); PG8_STAGE(PG8_SA(1, 0), a3, voffA);
            PG8_WAIT_V(8); PG8_WAIT_L(0); PG8_BAR; PG8_MMA(1, 0, At, B0); PG8_MMA(1, 1, At, B1); PG8_BAR; PG8_SCHED;
            } else {
            PG8_LDB(B0, 0, 0); PG8_SCHED; PG8_LDA(At, 0, 0); PG8_STAGE(PG8_SA(1, 1), a1 + hstep, voffA);
            PG8_WAIT_L(8); PG8_BAR; PG8_WAIT_L(0); PG8_MMA(0, 0, At, B0); PG8_BAR; PG8_SCHED;
            PG8_LDB(B1, 0, 1); PG8_STAGE(PG8_SB(0, 0), b2, voffB);
            PG8_BAR; PG8_WAIT_L(0); PG8_MMA(0, 1, At, B1); PG8_BAR;
            PG8_LDA(At, 0, 1); PG8_STAGE(PG8_SA(0, 0), a2, voffA);
            PG8_BAR; PG8_WAIT_L(0); PG8_MMA(1, 0, At, B0); PG8_BAR; PG8_SCHED;
            PG8_STAGE(PG8_SB(0, 1), b2 + hstep, voffB);
            PG8_WAIT_V(6); PG8_BAR; PG8_MMA(1, 1, At, B1); PG8_BAR;
            PG8_LDB(B0, 1, 0); PG8_SCHED; PG8_LDA(At, 1, 0); PG8_STAGE(PG8_SA(0, 1), a2 + hstep, voffA);
            PG8_WAIT_L(8); PG8_BAR; PG8_WAIT_L(0); PG8_MMA(0, 0, At, B0); PG8_BAR; PG8_SCHED;
            PG8_LDB(B1, 1, 1); PG8_STAGE(PG8_SB(1, 0), b3, voffB);
            PG8_BAR; PG8_WAIT_L(0); PG8_MMA(0, 1, At, B1); PG8_BAR;
            PG8_LDA(At, 1, 1); PG8_STAGE(PG8_SA(1, 0), a3, voffA);
            PG8_BAR; PG8_WAIT_L(0); PG8_MMA(1, 0, At, B0); PG8_BAR; PG8_SCHED;
            PG8_STAGE(PG8_SB(1, 1), b3 + hstep, voffB);
            PG8_WAIT_V(6); PG8_BAR; PG8_MMA(1, 1, At, B1); PG8_BAR;
            }
        }
        if constexpr (ALIGN_EPI) { if (wr == 0) PG8_BAR; }
        if constexpr (!Epi::AFTER_DRAIN) { E(acc, cur, wr, wc, fr, fq); S.done(cur); }
        if (!has_next) break;
#pragma unroll
        for (int a = 0; a < 2; ++a)
#pragma unroll
            for (int b = 0; b < 2; ++b)
#pragma unroll
                for (int m = 0; m < 4; ++m)
#pragma unroll
                    for (int n = 0; n < 2; ++n) acc[a][b][m][n] = (f32x4){0.f, 0.f, 0.f, 0.f};
        cur = nxt; cA = nA; cB = nB; ++ui;
        if constexpr (ALIGN_EPI) { if (wr == 1) PG8_BAR; }
    }
    PG8_WAIT_V(0);
    if constexpr (!ALIGN_EPI) { if (wr == 0) PG8_BAR; }
    PG8_BAR;
    if constexpr (Epi::AFTER_DRAIN) { E.fused(acc, cur, wr, wc, fr, fq, lds, wid, lane); S.done(cur); }
#undef PG8_SA
#undef PG8_SB
#undef PG8_STAGE
#undef PG8_LDA
#undef PG8_LDB
#undef PG8_MMA
#undef PG8_WAIT_V
#undef PG8_WAIT_L
#undef PG8_BAR
#undef PG8_SCHED
}
}

namespace cg = cooperative_groups;
#define LAS __attribute__((address_space(3)))
typedef unsigned short bf16_t;
typedef short bf16x8 __attribute__((ext_vector_type(8)));
typedef float f32x4 __attribute__((ext_vector_type(4)));
typedef float f32x2 __attribute__((ext_vector_type(2)));
typedef unsigned u32x4 __attribute__((ext_vector_type(4)));
typedef unsigned u32x2 __attribute__((ext_vector_type(2)));

constexpr int BATCH = 4, SEQ = 2048, D = 2048, FF = 5632, M = BATCH * SEQ;
constexpr int NG = 128, SP = 64, SH = 16;
constexpr int NQH = 32, NKVH = 4, HD = 64, KVW = 256;
constexpr int MODW = 9 * D;
constexpr int NWAVES = 8, NTHR = 512;
constexpr int LDS_BYTES = 147456;

constexpr size_t MiB = 1u << 20;
constexpr size_t WS_MOD0 = 0, WS_MOD1 = MiB / 2, WS_MODKV = 1 * MiB;
constexpr size_t WS_COS = 2 * MiB, WS_SIN = 3 * MiB, WS_LAM = 4 * MiB, WS_BBAR = 5 * MiB;
constexpr size_t WS_BAR = 4 * MiB + 524288;
constexpr size_t WS_GFLAG = 4 * MiB + 524288 + 32768;
constexpr size_t WS_CTL = 6 * MiB, WS_XBUF = 6 * MiB + 65536;
constexpr size_t WS_WFFIN = 8 * MiB;
constexpr size_t WS_WFFOUT = 184 * MiB;
constexpr size_t WS_WS5IN = 272 * MiB, WS_WS5GLU = 280 * MiB, WS_WS5OUT = 288 * MiB, WS_WQ = 296 * MiB, WS_WO = 304 * MiB, WS_WKV = 312 * MiB;
constexpr size_t WS_X = 320 * MiB;
constexpr size_t WS_XN = 384 * MiB, WS_XN2 = 416 * MiB;
constexpr size_t WS_H = 448 * MiB;
constexpr size_t WS_V = 536 * MiB;
constexpr size_t WS_Y = 600 * MiB, WS_Z = 632 * MiB, WS_Q = 664 * MiB, WS_O = 696 * MiB;
constexpr size_t WS_K = 728 * MiB, WS_VB = 732 * MiB;
constexpr size_t WS_END = 736 * MiB;

__device__ __forceinline__ float bf2f(unsigned short h) { return __uint_as_float(((unsigned)h) << 16); }
__device__ __forceinline__ float bflo(unsigned w) { return __uint_as_float(w << 16); }
__device__ __forceinline__ float bfhi(unsigned w) { return __uint_as_float(w & 0xffff0000u); }
__device__ __forceinline__ unsigned f2bf(float f) { unsigned u = __float_as_uint(f); return (u + 0x7fffu + ((u >> 16) & 1u)) >> 16; }
__device__ __forceinline__ unsigned pk2(float lo, float hi) { return f2bf(lo) | (f2bf(hi) << 16); }
__device__ __forceinline__ float fast_sigmoid(float x) { return __builtin_amdgcn_rcpf(1.0f + __builtin_amdgcn_exp2f(-1.4426950408889634f * x)); }
__device__ __forceinline__ float gelu_tanh(float x) { const float u = 0.7978845608028654f * (x + 0.044715f * x * x * x); return x * fast_sigmoid(2.0f * u); }
__device__ __forceinline__ f32x2 cmul(f32x2 a, f32x2 b) { return (f32x2){a.x * b.x - a.y * b.y, a.x * b.y + a.y * b.x}; }
__device__ __forceinline__ float wave_sum(float v) {
#pragma unroll
    for (int o = 1; o < 64; o <<= 1) v += __shfl_xor(v, o);
    return v;
}
__device__ __forceinline__ void sincos_d(double x, double& s, double& c) {
    const double k = __builtin_rint(x * 0.15915494309189535);
    double r = __builtin_fma(-k, 6.283185307179586, x); r = __builtin_fma(-k, 2.4492935982947064e-16, r);
    const double r2 = r * r;
    double ts = r, tc = 1.0, ss = r, cc = 1.0;
#pragma unroll
    for (int n = 1; n <= 14; ++n) {
        tc = -tc * r2 * (1.0 / (double)((2 * n - 1) * (2 * n)));
        ts = -ts * r2 * (1.0 / (double)((2 * n) * (2 * n + 1)));
        cc += tc; ss += ts;
    }
    s = ss; c = cc;
}
__device__ __forceinline__ double exp_d(double x) {
    const double k = __builtin_rint(x * 1.4426950408889634);
    double r = __builtin_fma(-k, 0.6931471805599453, x); r = __builtin_fma(-k, 2.3190468138462996e-17, r);
    double t = 1.0, e = 1.0;
#pragma unroll
    for (int n = 1; n <= 16; ++n) { t = t * r * (1.0 / (double)n); e += t; }
    return __builtin_ldexp(e, (int)k);
}

struct EpiSwiGLU {
    static constexpr bool PERM = true, AFTER_DRAIN = false;
    bf16_t* H;
    __device__ __forceinline__ void operator()(const f32x4 (&acc)[2][2][4][2], const pg8::Unit& u, int wr, int wc, int fr, int fq) const {
        const int row0 = u.pm * 256 + wr * 64 + fr, col0 = u.pn * 128 + wc * 32 + 8 * fq;
#pragma unroll
        for (int ai = 0; ai < 2; ++ai)
#pragma unroll
            for (int m = 0; m < 4; ++m) {
                bf16_t* rowp = H + (size_t)(row0 + ai * 128 + m * 16) * FF + col0;
                float h[8];
#pragma unroll
                for (int n = 0; n < 2; ++n)
#pragma unroll
                    for (int i = 0; i < 4; ++i) { const float g = acc[ai][0][m][n][i], up = acc[ai][1][m][n][i]; h[4 * n + i] = g * fast_sigmoid(g) * up; }
                u32x4 w; w.x = pg8::cvt_pk_bf16(h[0], h[1]); w.y = pg8::cvt_pk_bf16(h[2], h[3]); w.z = pg8::cvt_pk_bf16(h[4], h[5]); w.w = pg8::cvt_pk_bf16(h[6], h[7]);
                *(u32x4*)rowp = w;
            }
    }
};
struct EpiResid {
    static constexpr bool PERM = false, AFTER_DRAIN = false;
    const float* base; float* out; const float* gate; float coef;
    __device__ __forceinline__ void operator()(const f32x4 (&acc)[2][2][4][2], const pg8::Unit& u, int wr, int wc, int fr, int fq) const {
        const int row0 = u.pm * 256 + wr * 64 + fr, col0 = u.pn * 256 + wc * 32 + 4 * fq;
        const float* gp = gate + (size_t)(u.pm >> 3) * MODW + col0;
        f32x4 gv[2][2];
#pragma unroll
        for (int bj = 0; bj < 2; ++bj)
#pragma unroll
            for (int n = 0; n < 2; ++n) { const f32x4 t = *(const f32x4*)(gp + bj * 128 + n * 16); gv[bj][n] = (t + 1.0f) * coef; }
#pragma unroll
        for (int ai = 0; ai < 2; ++ai)
#pragma unroll
            for (int m = 0; m < 4; ++m) {
                const size_t off = (size_t)(row0 + ai * 128 + m * 16) * D + col0;
#pragma unroll
                for (int bj = 0; bj < 2; ++bj)
#pragma unroll
                    for (int n = 0; n < 2; ++n) { const f32x4 x = *(const f32x4*)(base + off + bj * 128 + n * 16); *(f32x4*)(out + off + bj * 128 + n * 16) = x + gv[bj][n] * acc[ai][bj][m][n]; }
                asm volatile("" ::: "memory");
            }
    }
};
struct EpiF32 {
    static constexpr bool PERM = false, AFTER_DRAIN = false;
    float* out;
    __device__ __forceinline__ void operator()(const f32x4 (&acc)[2][2][4][2], const pg8::Unit& u, int wr, int wc, int fr, int fq) const {
        const int row0 = u.pm * 256 + wr * 64 + fr, col0 = u.pn * 256 + wc * 32 + 4 * fq;
#pragma unroll
        for (int ai = 0; ai < 2; ++ai)
#pragma unroll
            for (int m = 0; m < 4; ++m) {
                const size_t off = (size_t)(row0 + ai * 128 + m * 16) * D + col0;
#pragma unroll
                for (int bj = 0; bj < 2; ++bj)
#pragma unroll
                    for (int n = 0; n < 2; ++n) *(f32x4*)(out + off + bj * 128 + n * 16) = acc[ai][bj][m][n];
            }
    }
};
struct EpiGLU {
    static constexpr bool PERM = true, AFTER_DRAIN = false;
    const bf16_t* Y; bf16_t* Z; const float* bias;
    __device__ __forceinline__ void operator()(const f32x4 (&acc)[2][2][4][2], const pg8::Unit& u, int wr, int wc, int fr, int fq) const {
        const int row0 = u.pm * 256 + wr * 64 + fr, col0 = u.pn * 256 + wc * 32 + 8 * fq;
        f32x4 bv[2][2];
#pragma unroll
        for (int bj = 0; bj < 2; ++bj)
#pragma unroll
            for (int n = 0; n < 2; ++n) bv[bj][n] = *(const f32x4*)(bias + col0 + bj * 128 + 4 * n);
#pragma unroll
        for (int ai = 0; ai < 2; ++ai)
#pragma unroll
            for (int m = 0; m < 4; ++m) {
                const size_t off = (size_t)(row0 + ai * 128 + m * 16) * D + col0;
#pragma unroll
                for (int bj = 0; bj < 2; ++bj) {
                    const u32x4 yv = *(const u32x4*)(Y + off + bj * 128);
                    const f32x4 a0 = acc[ai][bj][m][0] + bv[bj][0], a1 = acc[ai][bj][m][1] + bv[bj][1];
                    u32x4 w;
                    w.x = pg8::cvt_pk_bf16(bflo(yv.x) * fast_sigmoid(a0[0]), bfhi(yv.x) * fast_sigmoid(a0[1]));
                    w.y = pg8::cvt_pk_bf16(bflo(yv.y) * fast_sigmoid(a0[2]), bfhi(yv.y) * fast_sigmoid(a0[3]));
                    w.z = pg8::cvt_pk_bf16(bflo(yv.z) * fast_sigmoid(a1[0]), bfhi(yv.z) * fast_sigmoid(a1[1]));
                    w.w = pg8::cvt_pk_bf16(bflo(yv.w) * fast_sigmoid(a1[2]), bfhi(yv.w) * fast_sigmoid(a1[3]));
                    *(u32x4*)(Z + off + bj * 128) = w;
                }
                asm volatile("" ::: "memory");
            }
    }
};
struct EpiRope {
    static constexpr bool PERM = true, AFTER_DRAIN = false;
    bf16_t* out0; int ld0; bf16_t* out1; int ld1; int n_rope; const float* cosT; const float* sinT; float scale;
    __device__ __forceinline__ void operator()(const f32x4 (&acc)[2][2][4][2], const pg8::Unit& u, int wr, int wc, int fr, int fq) const {
        const int row0 = u.pm * 256 + wr * 64 + fr;
        if (u.pn < n_rope) {
            const int head = 4 * u.pn + wc;
#pragma unroll
            for (int ai = 0; ai < 2; ++ai)
#pragma unroll
                for (int m = 0; m < 4; ++m) {
                    const int row = row0 + ai * 128 + m * 16;
                    float o1[8], o2[8];
#pragma unroll
                    for (int n = 0; n < 2; ++n) {
                        const f32x4 cs = *(const f32x4*)(cosT + (size_t)row * 32 + 8 * fq + 4 * n), sn = *(const f32x4*)(sinT + (size_t)row * 32 + 8 * fq + 4 * n);
                        const f32x4 t1 = acc[ai][0][m][n], t2 = acc[ai][1][m][n];
#pragma unroll
                        for (int i = 0; i < 4; ++i) { o1[4 * n + i] = (t1[i] * cs[i] - t2[i] * sn[i]) * scale; o2[4 * n + i] = (t2[i] * cs[i] + t1[i] * sn[i]) * scale; }
                    }
                    bf16_t* rp = out0 + (size_t)row * ld0 + 64 * head + 8 * fq;
                    u32x4 w; w.x = pg8::cvt_pk_bf16(o1[0], o1[1]); w.y = pg8::cvt_pk_bf16(o1[2], o1[3]); w.z = pg8::cvt_pk_bf16(o1[4], o1[5]); w.w = pg8::cvt_pk_bf16(o1[6], o1[7]);
                    *(u32x4*)rp = w;
                    w.x = pg8::cvt_pk_bf16(o2[0], o2[1]); w.y = pg8::cvt_pk_bf16(o2[2], o2[3]); w.z = pg8::cvt_pk_bf16(o2[4], o2[5]); w.w = pg8::cvt_pk_bf16(o2[6], o2[7]);
                    *(u32x4*)(rp + 32) = w;
                    asm volatile("" ::: "memory");
                }
        } else {
            const int col0 = (u.pn - n_rope) * 256 + wc * 32 + 8 * fq;
#pragma unroll
            for (int ai = 0; ai < 2; ++ai)
#pragma unroll
                for (int m = 0; m < 4; ++m) {
                    bf16_t* rp = out1 + (size_t)(row0 + ai * 128 + m * 16) * ld1 + col0;
#pragma unroll
                    for (int bj = 0; bj < 2; ++bj) {
                        const f32x4 v0 = acc[ai][bj][m][0], v1 = acc[ai][bj][m][1];
                        u32x4 w; w.x = pg8::cvt_pk_bf16(v0[0], v0[1]); w.y = pg8::cvt_pk_bf16(v0[2], v0[3]); w.z = pg8::cvt_pk_bf16(v1[0], v1[1]); w.w = pg8::cvt_pk_bf16(v1[2], v1[3]);
                        *(u32x4*)(rp + bj * 128) = w;
                    }
                    asm volatile("" ::: "memory");
                }
        }
    }
};


struct EpiResidNorm {
    static constexpr bool PERM = false, AFTER_DRAIN = true;
    const float* base; float* out; const float* gate;
    int sidx;
    const float* normg; const float* fing; const float* sh1; const float* sc1; int bs1; bf16_t* o1;
    const float* g2; const float* sh2; const float* sc2; int bs2; bf16_t* o2;
    float* outf;
    unsigned* xbuf; unsigned* cnt;
    __device__ __forceinline__ void fused(f32x4 (&acc)[2][2][4][2], const pg8::Unit& u, int wr, int wc, int fr, int fq, PG8_LAS unsigned char* lds, int wid, int lane) const {
        const int mode = (sidx == 5) ? 2 : ((sidx == 2) ? 1 : 0);
        const float coef = (sidx % 3 != 1) ? 0.5f : 1.0f;
        const float* g1 = (sidx == 5) ? fing : normg + (size_t)(sidx + 1) * D;
        PG8_LAS float* P = (PG8_LAS float*)lds;
        PG8_LAS float* S = (PG8_LAS float*)(lds + 4096);
        const int b = u.pm >> 3, row0 = u.pm * 256 + wr * 64 + fr, col0 = u.pn * 256 + wc * 32 + 4 * fq;
        {
            const float* gp = gate + (size_t)b * MODW + col0;
            f32x4 gv[2][2];
#pragma unroll
            for (int bj = 0; bj < 2; ++bj)
#pragma unroll
                for (int n = 0; n < 2; ++n) { const f32x4 t = *(const f32x4*)(gp + bj * 128 + n * 16); gv[bj][n] = (t + 1.0f) * coef; }
#pragma unroll
            for (int ai = 0; ai < 2; ++ai)
#pragma unroll
                for (int m = 0; m < 4; ++m) {
                    const size_t off = (size_t)(row0 + ai * 128 + m * 16) * D + col0;
                    float ss = 0.f;
#pragma unroll
                    for (int bj = 0; bj < 2; ++bj)
#pragma unroll
                        for (int n = 0; n < 2; ++n) {
                            const f32x4 x = *(const f32x4*)(base + off + bj * 128 + n * 16);
                            const f32x4 v = x + gv[bj][n] * acc[ai][bj][m][n];
                            acc[ai][bj][m][n] = v;
                            if (mode != 2) *(f32x4*)(out + off + bj * 128 + n * 16) = v;
                            ss += (v.x * v.x + v.y * v.y) + (v.z * v.z + v.w * v.w);
                        }
                    ss += __shfl_xor(ss, 16); ss += __shfl_xor(ss, 32);
                    if (fq == 0) P[(ai * 128 + wr * 64 + m * 16 + fr) * 4 + wc] = ss;
                    asm volatile("" ::: "memory");
                }
        }
        asm volatile("s_waitcnt lgkmcnt(0)" ::: "memory"); __builtin_amdgcn_s_barrier(); asm volatile("" ::: "memory");
        const int row = wid * 32 + (lane & 31);
        if (lane < 32) {
            const float sp = (P[row * 4 + 0] + P[row * 4 + 1]) + (P[row * 4 + 2] + P[row * 4 + 3]);
            __hip_atomic_store(xbuf + ((size_t)(u.pm * 256 + row) * 8 + u.pn), __float_as_uint(sp), __ATOMIC_RELAXED, __HIP_MEMORY_SCOPE_AGENT);
        }
        asm volatile("s_waitcnt vmcnt(0)" ::: "memory");
        if (lane == 0) __hip_atomic_fetch_add(cnt + 64 * u.pm, 1u, __ATOMIC_RELAXED, __HIP_MEMORY_SCOPE_AGENT);
        if (wid == 0) {
            unsigned spins = 0;
            for (;;) {
                if ((unsigned)__builtin_amdgcn_readfirstlane(__hip_atomic_load(cnt + 64 * u.pm, __ATOMIC_RELAXED, __HIP_MEMORY_SCOPE_AGENT)) >= 64u) break;
                if (++spins > (1u << 22)) break;
                __builtin_amdgcn_s_sleep(2);
            }
            __builtin_amdgcn_fence(__ATOMIC_ACQUIRE, "agent");
        }
        asm volatile("s_waitcnt vmcnt(0) lgkmcnt(0)" ::: "memory"); __builtin_amdgcn_s_barrier(); asm volatile("" ::: "memory");
        if (lane < 32) {
            const unsigned* slot = xbuf + (size_t)(u.pm * 256 + row) * 8; float tot = 0.f;
#pragma unroll
            for (int t = 0; t < 8; ++t) tot += __uint_as_float(__hip_atomic_load(slot + t, __ATOMIC_RELAXED, __HIP_MEMORY_SCOPE_AGENT));
            S[row] = 1.0f / sqrtf(tot * (1.0f / D) + 1e-6f);
        }
        asm volatile("s_waitcnt lgkmcnt(0)" ::: "memory"); __builtin_amdgcn_s_barrier(); asm volatile("" ::: "memory");
#pragma unroll
        for (int bj = 0; bj < 2; ++bj)
#pragma unroll
            for (int n = 0; n < 2; ++n) {
                const int col = col0 + bj * 128 + n * 16;
                const f32x4 gg = *(const f32x4*)(g1 + col);
                f32x4 sc = (f32x4){0.f, 0.f, 0.f, 0.f}, sh = sc, gg2 = sc, sc2v = sc, sh2v = sc;
                if (mode != 2) { sc = *(const f32x4*)(sc1 + (size_t)b * bs1 + col) + 1.0f; sh = *(const f32x4*)(sh1 + (size_t)b * bs1 + col); }
                if (mode == 1) { gg2 = *(const f32x4*)(g2 + col); sc2v = *(const f32x4*)(sc2 + (size_t)b * bs2 + col) + 1.0f; sh2v = *(const f32x4*)(sh2 + (size_t)b * bs2 + col); }
#pragma unroll
                for (int ai = 0; ai < 2; ++ai)
#pragma unroll
                    for (int m = 0; m < 4; ++m) {
                        const int r = ai * 128 + wr * 64 + m * 16 + fr;
                        const size_t off = (size_t)(u.pm * 256 + r) * D + col;
                        const f32x4 xn = acc[ai][bj][m][n] * S[r];
                        if (mode == 2) { *(f32x4*)(outf + off) = xn * gg; }
                        else {
                            const f32x4 h = (xn * gg) * sc + sh;
                            u32x2 w; w.x = pg8::cvt_pk_bf16(h.x, h.y); w.y = pg8::cvt_pk_bf16(h.z, h.w);
                            *(u32x2*)(o1 + off) = w;
                            if (mode == 1) { const f32x4 h2 = (xn * gg2) * sc2v + sh2v; u32x2 w2; w2.x = pg8::cvt_pk_bf16(h2.x, h2.y); w2.y = pg8::cvt_pk_bf16(h2.z, h2.w); *(u32x2*)(o2 + off) = w2; }
                        }
                    }
                asm volatile("" ::: "memory");
            }
    }
};

struct Args { const float* in[28]; float* out; unsigned char* ws; };
enum { I_X = 0, I_C, I_POS, I_NORMG, I_WADA, I_BADA, I_WFFIN, I_WFFOUT, I_S5WIN, I_S5ARE, I_S5AIM, I_S5BRE, I_S5BIM, I_S5CRE, I_S5CIM, I_S5D, I_S5LOGDT, I_S5WGLU, I_S5BGLU, I_S5WOUT,
       I_KVG, I_WADAKV, I_BADAKV, I_WKV, I_WQ, I_SINKS, I_WO, I_FING };

__device__ __forceinline__ void xpose_item(const float* W, int K, int N, bf16_t* WT, int mode, int ropeN, LAS float* scr, int item, int lane) {
    const int nblk = N / 32, kb = item / nblk, nb = item % nblk, k0 = 128 * kb, n0 = 32 * nb;
    int drow = n0;
    if (mode == 1) { const int which = n0 / FF, j = n0 % FF; drow = 256 * (j / 128) + 128 * which + (j % 128); }
    else if (mode == 2 && n0 < ropeN) { const int head = n0 / 64, half = (n0 % 64) / 32; drow = 256 * (head / 4) + 128 * half + 32 * (head % 4); }
    const float* src = W + (size_t)(k0 + (lane >> 5)) * N + n0 + (lane & 31);
    float tv[64];
#pragma unroll
    for (int i = 0; i < 64; ++i) tv[i] = __builtin_nontemporal_load(src + (size_t)(2 * i) * N);
#pragma unroll
    for (int i = 0; i < 64; ++i) scr[(2 * i + (lane >> 5)) * 33 + (lane & 31)] = tv[i];
    asm volatile("s_waitcnt lgkmcnt(0)" ::: "memory");
    const int c = lane & 15;
#pragma unroll
    for (int j = 0; j < 8; ++j) { const int n = (lane >> 4) + 4 * j; const LAS float* s = scr + (8 * c) * 33 + n;
        u32x4 o; o.x = pg8::cvt_pk_bf16(s[0 * 33], s[1 * 33]); o.y = pg8::cvt_pk_bf16(s[2 * 33], s[3 * 33]); o.z = pg8::cvt_pk_bf16(s[4 * 33], s[5 * 33]); o.w = pg8::cvt_pk_bf16(s[6 * 33], s[7 * 33]);
        __builtin_nontemporal_store(o, (u32x4*)(WT + (size_t)(drow + n) * K + k0 + 8 * c)); }
    asm volatile("s_waitcnt lgkmcnt(0)" ::: "memory");
}

__device__ __forceinline__ void gemv_item(const float* W, int N, const float* bias, float* out, int chunk, const LAS f32x4* cact, LAS float* red, int tid, int wave, int lane, unsigned* flag = nullptr) {
    const float* wp = W + (size_t)(256 * wave) * N + 128 * chunk + 2 * lane;
    float a00 = 0.f, a01 = 0.f, a10 = 0.f, a11 = 0.f, a20 = 0.f, a21 = 0.f, a30 = 0.f, a31 = 0.f;
    for (int k = 0; k < 256; k += 16) {
        f32x2 w[16];
#pragma unroll
        for (int uu = 0; uu < 16; ++uu) w[uu] = __builtin_nontemporal_load((const f32x2*)(wp + (size_t)(k + uu) * N));
#pragma unroll
        for (int uu = 0; uu < 16; ++uu) { const f32x4 c = cact[256 * wave + k + uu];
            a00 += c.x * w[uu].x; a01 += c.x * w[uu].y; a10 += c.y * w[uu].x; a11 += c.y * w[uu].y; a20 += c.z * w[uu].x; a21 += c.z * w[uu].y; a30 += c.w * w[uu].x; a31 += c.w * w[uu].y; }
    }
    LAS float* r = red + (wave * 64 + lane) * 8;
    r[0] = a00; r[1] = a01; r[2] = a10; r[3] = a11; r[4] = a20; r[5] = a21; r[6] = a30; r[7] = a31;
    __syncthreads();
    { const int b = tid >> 7, col = tid & 127, l2 = col >> 1, j = col & 1; float s = bias[128 * chunk + col];
#pragma unroll
      for (int w2 = 0; w2 < 8; ++w2) s += red[(w2 * 64 + l2) * 8 + b * 2 + j];
      __hip_atomic_store(out + (size_t)b * N + 128 * chunk + col, s, __ATOMIC_RELAXED, __HIP_MEMORY_SCOPE_AGENT); }
    asm volatile("s_waitcnt vmcnt(0)" ::: "memory");
    __syncthreads();
    if (flag && tid == 0) __hip_atomic_fetch_add(flag, 1u, __ATOMIC_RELAXED, __HIP_MEMORY_SCOPE_AGENT);
}

template <int MODE  >
__device__ __forceinline__ void norm_phase(const float* x, const float* g1, const float* sh1, const float* sc1, int bstride1, bf16_t* out1,
                                           const float* g2, const float* sh2, const float* sc2, int bstride2, bf16_t* out2, float* outf, int wave, int lane) {
    const int gw = blockIdx.x * NWAVES + wave, NGW = gridDim.x * NWAVES;
    for (int row = gw; row < M; row += NGW) {
        const int b = row >> 11;
        const f32x4* xr = (const f32x4*)(x + (size_t)row * D) + lane;
        f32x4 v[8]; float s = 0.f;
#pragma unroll
        for (int j = 0; j < 8; ++j) { v[j] = xr[64 * j]; s += (v[j].x * v[j].x + v[j].y * v[j].y) + (v[j].z * v[j].z + v[j].w * v[j].w); }
        const float rstd = 1.0f / sqrtf(wave_sum(s) * (1.0f / D) + 1e-6f);
#pragma unroll
        for (int j = 0; j < 8; ++j) {
            const int col = 4 * (lane + 64 * j);
            const f32x4 gg = *(const f32x4*)(g1 + col);
            const f32x4 xn = v[j] * rstd;
            if (MODE == 2) { *(f32x4*)(outf + (size_t)row * D + col) = xn * gg; }
            else {
                const f32x4 sc = *(const f32x4*)(sc1 + (size_t)b * bstride1 + col), sh = *(const f32x4*)(sh1 + (size_t)b * bstride1 + col);
                const f32x4 h = (xn * gg) * (sc + 1.0f) + sh;
                u32x2 w; w.x = pg8::cvt_pk_bf16(h.x, h.y); w.y = pg8::cvt_pk_bf16(h.z, h.w);
                *(u32x2*)(out1 + (size_t)row * D + col) = w;
                if (MODE == 1) {
                    const f32x4 gg2 = *(const f32x4*)(g2 + col), sc2v = *(const f32x4*)(sc2 + (size_t)b * bstride2 + col), sh2v = *(const f32x4*)(sh2 + (size_t)b * bstride2 + col);
                    const f32x4 h2 = (xn * gg2) * (sc2v + 1.0f) + sh2v;
                    u32x2 w2; w2.x = pg8::cvt_pk_bf16(h2.x, h2.y); w2.y = pg8::cvt_pk_bf16(h2.z, h2.w);
                    *(u32x2*)(out2 + (size_t)row * D + col) = w2;
                }
            }
        }
    }
}

__device__ __forceinline__ void norm1_phase(const float* x, const float* g1, const float* sh1, const float* sc1, int bstride1, bf16_t* out1, int wave, int lane) {
    const int gw = blockIdx.x * NWAVES + wave, NGW = gridDim.x * NWAVES;
    for (int rowb = gw; rowb < M; rowb += 4 * NGW) {
        f32x4 v[4][8];
#pragma unroll
        for (int r = 0; r < 4; ++r) { const int row = rowb + r * NGW; const f32x4* xr = (const f32x4*)(x + (size_t)(row < M ? row : rowb) * D) + lane;
#pragma unroll
            for (int j = 0; j < 8; ++j) v[r][j] = __builtin_nontemporal_load(xr + 64 * j); }
#pragma unroll
        for (int r = 0; r < 4; ++r) {
            const int row = rowb + r * NGW; if (row >= M) break;
            const int b = row >> 11;
            float s = 0.f;
#pragma unroll
            for (int j = 0; j < 8; ++j) s += (v[r][j].x * v[r][j].x + v[r][j].y * v[r][j].y) + (v[r][j].z * v[r][j].z + v[r][j].w * v[r][j].w);
            const float rstd = 1.0f / sqrtf(wave_sum(s) * (1.0f / D) + 1e-6f);
#pragma unroll
            for (int j = 0; j < 8; ++j) {
                const int col = 4 * (lane + 64 * j);
                const f32x4 gg = *(const f32x4*)(g1 + col);
                const f32x4 sc = *(const f32x4*)(sc1 + (size_t)b * bstride1 + col), sh = *(const f32x4*)(sh1 + (size_t)b * bstride1 + col);
                const f32x4 h = ((v[r][j] * rstd) * gg) * (sc + 1.0f) + sh;
                u32x2 w; w.x = pg8::cvt_pk_bf16(h.x, h.y); w.y = pg8::cvt_pk_bf16(h.z, h.w);
                *(u32x2*)(out1 + (size_t)row * D + col) = w;
            }
        }
    }
}

typedef float f32x16 __attribute__((ext_vector_type(16)));
__device__ __forceinline__ f32x2 cfma(f32x2 a, f32x2 b, f32x2 c) { return (f32x2){a.x * b.x - a.y * b.y + c.x, a.x * b.y + a.y * b.x + c.y}; }
__device__ __forceinline__ void s5_scan_phase(LAS unsigned char* lds, const bf16_t* Vb, bf16_t* Yg, const f32x2* LAM, const f32x2* BBAR,
                                              const float* c_re, const float* c_im, const float* dskip, int tid, int wave, int lane) {
    const int half = lane >> 5, p32 = lane & 31, t16 = lane & 15, kg = lane >> 4;
    LAS unsigned char* img = lds + wave * 8704;
    LAS f32x2* Ech = (LAS f32x2*)(lds + 8 * 8704);
    for (int sp0 = blockIdx.x; sp0 < (BATCH * NG) / 2; sp0 += gridDim.x) {
        const int sp = (gridDim.x == 256) ? ((sp0 & 7) * 32 + (sp0 >> 3)) : sp0;
        const int sq = wave >> 2, chunk = wave & 3, seq = 2 * sp + sq, b = seq >> 7, g = seq & 127;
        const size_t row0 = (size_t)b * SEQ + (size_t)chunk * 512;
        bf16x8 bfr[4];
        f32x2 lam1[2], lam2[2], lam3[2], lam4[2];
#pragma unroll
        for (int pb = 0; pb < 2; ++pb) {
            const f32x4* bp = (const f32x4*)(BBAR + ((size_t)(g * 64 + 32 * pb + p32)) * 16 + 8 * half);
            const f32x4 t0 = bp[0], t1 = bp[1], t2 = bp[2], t3 = bp[3];
            u32x4 wr_, wi_;
            wr_.x = pg8::cvt_pk_bf16(t0.x, t0.z); wr_.y = pg8::cvt_pk_bf16(t1.x, t1.z); wr_.z = pg8::cvt_pk_bf16(t2.x, t2.z); wr_.w = pg8::cvt_pk_bf16(t3.x, t3.z);
            wi_.x = pg8::cvt_pk_bf16(t0.y, t0.w); wi_.y = pg8::cvt_pk_bf16(t1.y, t1.w); wi_.z = pg8::cvt_pk_bf16(t2.y, t2.w); wi_.w = pg8::cvt_pk_bf16(t3.y, t3.w);
            bfr[2 * pb] = __builtin_bit_cast(bf16x8, wr_); bfr[2 * pb + 1] = __builtin_bit_cast(bf16x8, wi_);
            lam1[pb] = LAM[g * 64 + 32 * pb + p32]; lam2[pb] = cmul(lam1[pb], lam1[pb]); lam3[pb] = cmul(lam2[pb], lam1[pb]); lam4[pb] = cmul(lam2[pb], lam2[pb]);
        }
        bf16x8 cfr[4];
#pragma unroll
        for (int kb = 0; kb < 4; ++kb) {
            const size_t co = ((size_t)g * 16 + t16) * 64 + 16 * kb + 4 * kg;
            const f32x4 cr = *(const f32x4*)(c_re + co), ci = *(const f32x4*)(c_im + co);
            u32x4 w; w.x = pg8::cvt_pk_bf16(cr.x, -ci.x); w.y = pg8::cvt_pk_bf16(cr.y, -ci.y); w.z = pg8::cvt_pk_bf16(cr.z, -ci.z); w.w = pg8::cvt_pk_bf16(cr.w, -ci.w);
            cfr[kb] = __builtin_bit_cast(bf16x8, w);
        }
        bf16x8 dfr;
        { const unsigned db = f2bf(dskip[g * 16 + t16]); u32x4 w;
          const int e0 = t16 - 8 * kg;
          w.x = (kg < 2 && e0 == 0) ? db : ((kg < 2 && e0 == 1) ? (db << 16) : 0u);
          w.y = (kg < 2 && e0 == 2) ? db : ((kg < 2 && e0 == 3) ? (db << 16) : 0u);
          w.z = (kg < 2 && e0 == 4) ? db : ((kg < 2 && e0 == 5) ? (db << 16) : 0u);
          w.w = (kg < 2 && e0 == 6) ? db : ((kg < 2 && e0 == 7) ? (db << 16) : 0u);
          dfr = __builtin_bit_cast(bf16x8, w); }
        f32x2 cin[2]; cin[0] = (f32x2){0.f, 0.f}; cin[1] = (f32x2){0.f, 0.f};
        const bf16_t* vA = Vb + (row0 + (8 * (p32 & 3) + 4 * ((p32 >> 2) & 1) + (p32 >> 3))) * D + g * 16 + 8 * half;
        const bf16_t* vS = Vb + (row0 + t16) * D + g * 16 + 8 * (kg & 1);
        for (int pass = 0; pass < 2; ++pass) {
            f32x2 c[2]; c[0] = cin[0]; c[1] = cin[1];
            bf16x8 vnext = *(const bf16x8*)vA;
            bf16x8 snext0 = (bf16x8){0, 0, 0, 0, 0, 0, 0, 0}, snext1 = snext0;
            if (pass == 1 && kg < 2) { snext0 = *(const bf16x8*)vS; snext1 = *(const bf16x8*)(vS + (size_t)16 * D); }
            for (int blk = 0; blk < 16; ++blk) {
                const bf16x8 vcur = vnext, sk0 = snext0, sk1 = snext1;
                if (blk + 1 < 16) {
                    vnext = *(const bf16x8*)(vA + (size_t)(blk + 1) * 32 * D);
                    if (pass == 1 && kg < 2) { snext0 = *(const bf16x8*)(vS + (size_t)((blk + 1) * 32) * D); snext1 = *(const bf16x8*)(vS + (size_t)((blk + 1) * 32 + 16) * D); }
                }
#pragma unroll
                for (int pb = 0; pb < 2; ++pb) {
                    f32x16 re, im;
                    { f32x16 z;
#pragma unroll
                      for (int i = 0; i < 16; ++i) z[i] = 0.f;
                      re = __builtin_amdgcn_mfma_f32_32x32x16_bf16(vcur, bfr[2 * pb], z, 0, 0, 0);
                      im = __builtin_amdgcn_mfma_f32_32x32x16_bf16(vcur, bfr[2 * pb + 1], z, 0, 0, 0); }
                    const f32x2 l1 = lam1[pb], l2 = lam2[pb], l3 = lam3[pb], l4 = lam4[pb];
                    f32x2 R[8], I[8];
#pragma unroll
                    for (int q = 0; q < 8; ++q) { R[q] = (f32x2){re[2 * q], re[2 * q + 1]}; I[q] = (f32x2){im[2 * q], im[2 * q + 1]}; }
#pragma unroll
                    for (int j = 1; j < 4; ++j)
#pragma unroll
                        for (int u = 0; u < 2; ++u) {
                            const f32x2 rp = R[2 * (j - 1) + u], ip = I[2 * (j - 1) + u];
                            R[2 * j + u] = (R[2 * j + u] + rp * l1.x) - ip * l1.y;
                            I[2 * j + u] = (I[2 * j + u] + ip * l1.x) + rp * l1.y;
                        }
                    f32x2 e[4], o[4];
#pragma unroll
                    for (int k = 0; k < 4; ++k) {
                        const float ex = R[6 + (k >> 1)][k & 1], ey = I[6 + (k >> 1)][k & 1];
                        const auto sx = __builtin_amdgcn_permlane32_swap(__float_as_uint(ex), __float_as_uint(ex), false, false);
                        const auto sy = __builtin_amdgcn_permlane32_swap(__float_as_uint(ey), __float_as_uint(ey), false, false);
                        e[k] = (f32x2){__uint_as_float(sx[0]), __uint_as_float(sy[0])}; o[k] = (f32x2){__uint_as_float(sx[1]), __uint_as_float(sy[1])};
                    }
                    f32x2 cc = c[pb], mc[4];
#pragma unroll
                    for (int k = 0; k < 4; ++k) {
                        const f32x2 eh0 = e[k], eh1 = o[k];
                        const f32x2 c0 = cc; cc = cfma(l4, cc, eh0);
                        const f32x2 c1 = cc; cc = cfma(l4, cc, eh1);
                        mc[k] = half ? c1 : c0;
                    }
                    c[pb] = cc;
                    if (pass == 1) {
#pragma unroll
                        for (int u = 0; u < 2; ++u) {
                            const f32x2 mr = (f32x2){mc[2 * u].x, mc[2 * u + 1].x}, mi = (f32x2){mc[2 * u].y, mc[2 * u + 1].y};
                            R[0 + u] = (R[0 + u] + mr * l1.x) - mi * l1.y; I[0 + u] = (I[0 + u] + mi * l1.x) + mr * l1.y;
                            R[2 + u] = (R[2 + u] + mr * l2.x) - mi * l2.y; I[2 + u] = (I[2 + u] + mi * l2.x) + mr * l2.y;
                            R[4 + u] = (R[4 + u] + mr * l3.x) - mi * l3.y; I[4 + u] = (I[4 + u] + mi * l3.x) + mr * l3.y;
                            R[6 + u] = (R[6 + u] + mr * l4.x) - mi * l4.y; I[6 + u] = (I[6 + u] + mi * l4.x) + mr * l4.y;
                        }
#pragma unroll
                        for (int i = 0; i < 16; ++i) {
                            const int t = 8 * (i & 3) + 4 * half + (i >> 2);
                            *(LAS unsigned*)(img + t * 272 + 128 * pb + 4 * p32) = pg8::cvt_pk_bf16(R[i >> 1][i & 1], I[i >> 1][i & 1]);
                        }
                    }
                }
                asm volatile("" : "+v"(vnext), "+v"(snext0), "+v"(snext1));
                if (pass == 1) {
#pragma unroll
                    for (int tb = 0; tb < 2; ++tb) {
                        f32x4 y = (f32x4){0.f, 0.f, 0.f, 0.f};
#pragma unroll
                        for (int kb = 0; kb < 4; ++kb) {
                            const bf16x8 sf = *(const LAS bf16x8*)(img + (16 * tb + t16) * 272 + (32 * kb + 8 * kg) * 2);
                            y = __builtin_amdgcn_mfma_f32_16x16x32_bf16(cfr[kb], sf, y, 0, 0, 0);
                        }
                        y = __builtin_amdgcn_mfma_f32_16x16x32_bf16(dfr, tb ? sk1 : sk0, y, 0, 0, 0);
                        u32x2 w; w.x = pg8::cvt_pk_bf16(gelu_tanh(y.x), gelu_tanh(y.y)); w.y = pg8::cvt_pk_bf16(gelu_tanh(y.z), gelu_tanh(y.w));
                        *(u32x2*)(Yg + (row0 + (size_t)(blk * 32 + 16 * tb + t16)) * D + g * 16 + 4 * kg) = w;
                    }
                }
            }
            if (pass == 0) {
                if (lane < 32) { Ech[((sq * 4 + chunk) * 2 + 0) * 32 + p32] = c[0]; Ech[((sq * 4 + chunk) * 2 + 1) * 32 + p32] = c[1]; }
                __syncthreads();
#pragma unroll
                for (int pb = 0; pb < 2; ++pb) {
                    f32x2 lp = lam4[pb];
#pragma unroll
                    for (int q = 0; q < 7; ++q) lp = cmul(lp, lp);
                    f32x2 ci_ = (f32x2){0.f, 0.f};
                    for (int cc = 0; cc < chunk; ++cc) ci_ = cfma(lp, ci_, Ech[((sq * 4 + cc) * 2 + pb) * 32 + p32]);
                    cin[pb] = ci_;
                }
            }
        }
        __syncthreads();
    }
}

__device__ __forceinline__ void attn_phase(LAS unsigned char* lds, const bf16_t* Q, const bf16_t* Kb, const bf16_t* Vb, bf16_t* O, const float* sinks, int tid, int wave, int lane) {
    constexpr int KS = 144, VS = 528;
    LAS unsigned char* Kl = lds;
    LAS unsigned char* Vt = lds + 256 * KS;
    const int q16 = lane & 15, g = lane >> 4;
    for (int unit = blockIdx.x; unit < BATCH * 16 * NKVH; unit += gridDim.x) {
        const int kvh = unit & 3, nb = (unit >> 2) & 15, b = unit >> 6;
        for (int e = tid; e < 2048; e += NTHR) {
            const int key = e >> 3, part = e & 7, pos = (nb - 1) * 128 + key;
            u32x4 kv = (u32x4){0u, 0u, 0u, 0u}, vv = (u32x4){0u, 0u, 0u, 0u};
            if (pos >= 0) { const size_t off = ((size_t)b * SEQ + pos) * KVW + kvh * 64 + part * 8; kv = *(const u32x4*)(Kb + off); vv = *(const u32x4*)(Vb + off); }
            *(LAS u32x4*)(Kl + key * KS + part * 16) = kv;
            const int kb = key >> 5, kk = key & 31;
            const int slot = 32 * kb + ((kk & 16) ? (8 * ((kk - 16) >> 2) + 4 + (kk & 3)) : (8 * (kk >> 2) + (kk & 3)));
            LAS unsigned short* vp = (LAS unsigned short*)(Vt + (part * 8) * VS + slot * 2);
            vp[0 * (VS / 2)] = (unsigned short)(vv.x & 0xffffu); vp[1 * (VS / 2)] = (unsigned short)(vv.x >> 16);
            vp[2 * (VS / 2)] = (unsigned short)(vv.y & 0xffffu); vp[3 * (VS / 2)] = (unsigned short)(vv.y >> 16);
            vp[4 * (VS / 2)] = (unsigned short)(vv.z & 0xffffu); vp[5 * (VS / 2)] = (unsigned short)(vv.z >> 16);
            vp[6 * (VS / 2)] = (unsigned short)(vv.w & 0xffffu); vp[7 * (VS / 2)] = (unsigned short)(vv.w >> 16);
        }
        __syncthreads();
        const int hq = kvh * 8 + wave; const float sink2 = sinks[hq] * 1.4426950408889634f;
        const size_t rowbase = (size_t)b * SEQ + nb * 128;
        bf16x8 qfa[8], qfb[8];
#pragma unroll
        for (int qs = 0; qs < 8; ++qs) { const size_t qrow = rowbase + 16 * qs + q16; qfa[qs] = *(const bf16x8*)(Q + qrow * D + hq * 64 + 8 * g); qfb[qs] = *(const bf16x8*)(Q + qrow * D + hq * 64 + 32 + 8 * g); }
#pragma unroll
        for (int qs = 0; qs < 8; ++qs) {
            const bf16x8 qf0 = qfa[qs], qf1 = qfb[qs];
            const int kb0 = 2 * (qs >> 1);
            f32x4 sc[10];
#pragma unroll
            for (int kb = 0; kb < 10; ++kb) {
                const LAS unsigned char* kp = Kl + (16 * (kb0 + kb) + q16) * KS + g * 16;
                const bf16x8 k0 = *(const LAS bf16x8*)kp, k1 = *(const LAS bf16x8*)(kp + 64);
                f32x4 a = (f32x4){0.f, 0.f, 0.f, 0.f};
                a = __builtin_amdgcn_mfma_f32_16x16x32_bf16(k0, qf0, a, 0, 0, 0);
                a = __builtin_amdgcn_mfma_f32_16x16x32_bf16(k1, qf1, a, 0, 0, 0);
                sc[kb] = a;
            }
            const int L0 = 16 * (qs - kb0) + q16 - 4 * g;
            const int L = (nb == 0) ? max(L0, 127 - 16 * kb0 - 4 * g) : L0;
            float mx = sink2;
#pragma unroll
            for (int kb = 0; kb < 10; ++kb)
#pragma unroll
                for (int i = 0; i < 4; ++i) {
                    const int c = 16 * kb + i;
                    bool valid = c > L;
                    if (kb >= 7) valid = valid && (c <= L0 + 128);
                    const float sv = valid ? sc[kb][i] : -__builtin_inff();
                    sc[kb][i] = sv; mx = fmaxf(mx, sv);
                }
            mx = fmaxf(mx, __shfl_xor(mx, 16)); mx = fmaxf(mx, __shfl_xor(mx, 32));
            float sum = 0.f;
#pragma unroll
            for (int kb = 0; kb < 10; ++kb)
#pragma unroll
                for (int i = 0; i < 4; ++i) { const float pv = __builtin_amdgcn_exp2f(sc[kb][i] - mx); sc[kb][i] = pv; sum += pv; }
            sum += __shfl_xor(sum, 16); sum += __shfl_xor(sum, 32);
            sum += __builtin_amdgcn_exp2f(sink2 - mx);
            const float inv = 1.0f / sum;
            f32x4 o[4];
#pragma unroll
            for (int db = 0; db < 4; ++db) o[db] = (f32x4){0.f, 0.f, 0.f, 0.f};
#pragma unroll
            for (int j = 0; j < 5; ++j) {
                u32x4 pw;
                pw.x = pg8::cvt_pk_bf16(sc[2 * j][0], sc[2 * j][1]); pw.y = pg8::cvt_pk_bf16(sc[2 * j][2], sc[2 * j][3]);
                pw.z = pg8::cvt_pk_bf16(sc[2 * j + 1][0], sc[2 * j + 1][1]); pw.w = pg8::cvt_pk_bf16(sc[2 * j + 1][2], sc[2 * j + 1][3]);
                const bf16x8 pa = __builtin_bit_cast(bf16x8, pw);
#pragma unroll
                for (int db = 0; db < 4; ++db) {
                    const bf16x8 vf = *(const LAS bf16x8*)(Vt + (16 * db + q16) * VS + (32 * ((qs >> 1) + j) + 8 * g) * 2);
                    o[db] = __builtin_amdgcn_mfma_f32_16x16x32_bf16(vf, pa, o[db], 0, 0, 0);
                }
            }
#pragma unroll
            for (int db = 0; db < 4; ++db) {
                const f32x4 ov = o[db] * inv;
                u32x2 w; w.x = pg8::cvt_pk_bf16(ov.x, ov.y); w.y = pg8::cvt_pk_bf16(ov.z, ov.w);
                *(u32x2*)(O + (rowbase + 16 * qs + q16) * D + hq * 64 + 16 * db + 4 * g) = w;
            }
        }
        __syncthreads();
    }
}

#define GEMM_PHASE(EpiT, E, Aptr, Bptr, Nn, Kk) do { pg8::Gemm g_{(const bf16_t*)(Aptr), (const bf16_t*)(Bptr), M, (Nn), (Kk)}; pg8::StaticOrder S_; S_.init(M, (Nn), (int)gridDim.x, (int)blockIdx.x); \
    pg8::gemm_phase<EpiT, pg8::StaticOrder, true, true>(ldsb, g_, S_, E); } while (0)

#define XB_TMO      128
#define XB_XCNT(j)  (256  + 64 * (j))
#define XB_XSUB(j)  (1280 + 64 * (j))
#define XB_XGEN(j)  (2304 + 64 * (j))
#define XB_TOP      3328
#define XB_TOPGEN   3392
#define XCD_BAR_WORDS 3456
#define XB_SPIN_CAP (1u << 18)

__device__ __forceinline__ unsigned xb_ld(unsigned* p)              { return __hip_atomic_load(p, __ATOMIC_RELAXED, __HIP_MEMORY_SCOPE_AGENT); }
__device__ __forceinline__ unsigned xb_add(unsigned* p, unsigned v) { return __hip_atomic_fetch_add(p, v, __ATOMIC_RELAXED, __HIP_MEMORY_SCOPE_AGENT); }
__device__ __forceinline__ unsigned xb_xcc_id() { return (unsigned)__builtin_amdgcn_s_getreg((3 << 11) | 20) & 0xFu; }
#define XB_SPIN(cond, bar) do { unsigned _sp = 0; while (cond) { __builtin_amdgcn_s_sleep(1); \
    if ((++_sp & 255u) == 0u) { if (xb_ld(&(bar)[XB_TMO])) break; if (_sp > XB_SPIN_CAP) { atomicAdd(&(bar)[XB_TMO], 1u); break; } } } } while (0)

struct XcdBarrier {
    unsigned* bar; unsigned x;
    volatile LAS unsigned* st;
};

__device__ __forceinline__ XcdBarrier xcd_barrier_post(unsigned* bar, volatile LAS unsigned* st) {
    XcdBarrier b; b.bar = bar; b.x = xb_xcc_id(); b.st = st;
    if (threadIdx.x == 0) (void)xb_add(&bar[XB_XCNT(b.x)], 1u);
    return b;
}
__device__ __forceinline__ void xcd_barrier_complete(unsigned* bar, unsigned x, unsigned& nloc, unsigned& nx) {
    const unsigned G = gridDim.x * gridDim.y * gridDim.z;
    unsigned sum, cnt, mine, sp = 0u;
    for (;;) {
        sum = 0u; cnt = 0u; mine = 0u;
#pragma unroll
        for (unsigned j = 0; j < 16; ++j) { const unsigned c = xb_ld(&bar[XB_XCNT(j)]); sum += c; cnt += (c > 0u) ? 1u : 0u; mine = (j == x) ? c : mine; }
        if (sum == G) break;
        __builtin_amdgcn_s_sleep(1);
        if ((++sp & 255u) == 0u) { if (xb_ld(&bar[XB_TMO])) break; if (sp > XB_SPIN_CAP) { atomicAdd(&bar[XB_TMO], 1u); break; } }
    }
    nloc = mine > 0u ? mine : 1u; nx = cnt > 0u ? cnt : 1u;
}

__device__ __forceinline__ void xcd_barrier(const XcdBarrier& b) {
    asm volatile("s_waitcnt vmcnt(0)" ::: "memory");
    __syncthreads();
    if (threadIdx.x == 0) {
        unsigned* bar = b.bar;
        __builtin_amdgcn_s_waitcnt(0);
        unsigned nloc = b.st[0], nx = b.st[1];
        if (nloc == 0u) { xcd_barrier_complete(bar, b.x, nloc, nx); b.st[0] = nloc; b.st[1] = nx; }
        const unsigned old = xb_add(&bar[XB_XSUB(b.x)], 1u);
        const unsigned gen = old / nloc;
        if (old + 1u == (gen + 1u) * nloc) {
            __builtin_amdgcn_fence(__ATOMIC_RELEASE, "agent");
            asm volatile("s_waitcnt vmcnt(0)" ::: "memory");
            const unsigned og = xb_add(&bar[XB_TOP], 1u);
            const unsigned tg = og / nx;
            if (og + 1u == (tg + 1u) * nx) xb_add(&bar[XB_TOPGEN], 1u);
            else XB_SPIN(xb_ld(&bar[XB_TOPGEN]) == tg, bar);
            __builtin_amdgcn_fence(__ATOMIC_ACQUIRE, "agent");
            xb_add(&bar[XB_XGEN(b.x)], 1u);
            asm volatile("s_waitcnt vmcnt(0)" ::: "memory");
        } else {
            XB_SPIN(xb_ld(&bar[XB_XGEN(b.x)]) == gen, bar);
            __builtin_amdgcn_fence(__ATOMIC_ACQUIRE, "agent");
            asm volatile("s_waitcnt vmcnt(0)" ::: "memory");
        }
    }
    __syncthreads();
}

typedef const Args __attribute__((address_space(4)))* KArgs;
#define GETARGS() KArgs ka = (KArgs)__builtin_amdgcn_kernarg_segment_ptr(); asm volatile("" : "+s"(ka)); unsigned char* ws = ka->ws
#define LAUNDER_TID() int tid = threadIdx.x; asm volatile("" : "+v"(tid)); const int lane = tid & 63, wave = __builtin_amdgcn_readfirstlane(tid >> 6)
#define WSP(T, off) ((T*)(ws + (off)))
#ifndef SYNC_REPS
#define SYNC_REPS 1
#endif
#define GSYNC() do { for (int r_ = 0; r_ < SYNC_REPS; ++r_) xcd_barrier(xbar); } while (0)
#ifndef REP_P0
#define REP_P0 1
#define REP_NORM 1
#define REP_SCAN 1
#define REP_ATTN 1
#endif
#define XPOSE_MATS(mask, active, gw_, NGW_) do { \
    for (int mv = 0; mv < 22; ++mv) { if (!(((mask) >> mv) & 1u)) continue; \
        const int mi = mv < 14 ? mv : ((mv - 14) >> 1);        \
        const float* W; bf16_t* WT; int K, N, mode = 0, ropeN = 0; \
        if (mi < 4) { W = ka->in[I_WFFIN] + (size_t)mi * D * 2 * FF; WT = WSP(bf16_t, WS_WFFIN) + (size_t)mi * D * 2 * FF; K = D; N = 2 * FF; mode = 1; } \
        else if (mi < 8) { W = ka->in[I_WFFOUT] + (size_t)(mi - 4) * FF * D; WT = WSP(bf16_t, WS_WFFOUT) + (size_t)(mi - 4) * FF * D; K = FF; N = D; } \
        else if (mi == 8) { W = ka->in[I_S5WIN]; WT = WSP(bf16_t, WS_WS5IN); K = D; N = D; } \
        else if (mi == 9) { W = ka->in[I_S5WGLU]; WT = WSP(bf16_t, WS_WS5GLU); K = D; N = D; } \
        else if (mi == 10) { W = ka->in[I_S5WOUT]; WT = WSP(bf16_t, WS_WS5OUT); K = D; N = D; } \
        else if (mi == 11) { W = ka->in[I_WQ]; WT = WSP(bf16_t, WS_WQ); K = D; N = D; mode = 2; ropeN = D; } \
        else if (mi == 12) { W = ka->in[I_WO]; WT = WSP(bf16_t, WS_WO); K = D; N = D; } \
        else { W = ka->in[I_WKV]; WT = WSP(bf16_t, WS_WKV); K = D; N = 2 * KVW; mode = 2; ropeN = KVW; } \
        const int nitems = (K / 128) * (N / 32); \
        const int lo_ = (mv >= 14 && ((mv - 14) & 1)) ? nitems / 2 : 0, hi_ = (mv >= 14 && !((mv - 14) & 1)) ? nitems / 2 : nitems; \
        if (active) for (int it = lo_ + (gw_); it < hi_; it += (NGW_)) xpose_item(W, K, N, WT, mode, ropeN, scr, it, lane); \
    } } while (0)
__global__ void __launch_bounds__(NTHR, 2) yoco_fwd(Args args) {
    extern __shared__ __attribute__((aligned(16))) unsigned char lds[];
    LAS unsigned char* ldsb = (LAS unsigned char*)lds;
    cg::grid_group grid = cg::this_grid();
    if (threadIdx.x < 16) ((volatile LAS unsigned*)(ldsb + 147200))[threadIdx.x] = 0u;
    __syncthreads();

    for (int rep_ = 0; rep_ < REP_P0; ++rep_) {
        if (rep_) grid.sync();
        GETARGS(); LAUNDER_TID();
        float* MOD0 = WSP(float, WS_MOD0); float* MODKV = WSP(float, WS_MODKV);
        LAS f32x4* cact = (LAS f32x4*)ldsb;
        LAS float* red = (LAS float*)(ldsb + 32768);
        LAS float* scr = (LAS float*)(ldsb + wave * 16896);
        { const float* cin = ka->in[I_C];
          for (int i = tid; i < BATCH * D; i += NTHR) { const int b = i >> 11, k = i & 2047; const float v = cin[i]; ((LAS float*)cact)[k * 4 + b] = v * fast_sigmoid(v); } }
        __syncthreads();
        for (int it = blockIdx.x; it < 320; it += gridDim.x) {
            if (it < 288) { const int l = it / 144, ch = it % 144; gemv_item(ka->in[I_WADA] + (size_t)l * D * MODW, MODW, ka->in[I_BADA] + (size_t)l * MODW, MOD0 + (size_t)l * (WS_MOD1 / 4), ch, cact, red, tid, wave, lane, it < 32 ? WSP(unsigned, WS_GFLAG) : nullptr); }
            else gemv_item(ka->in[I_WADAKV], 2 * D, ka->in[I_BADAKV], MODKV, it - 288, cact, red, tid, wave, lane);
        }
        if (rep_ == 0) {
            if (wave == 0) { unsigned spins = 0; unsigned* gf = WSP(unsigned, WS_GFLAG);
                while ((unsigned)__builtin_amdgcn_readfirstlane(__hip_atomic_load(gf, __ATOMIC_RELAXED, __HIP_MEMORY_SCOPE_AGENT)) < 32u) { if (++spins > (1u << 22)) break; __builtin_amdgcn_s_sleep(2); }
                __builtin_amdgcn_fence(__ATOMIC_ACQUIRE, "agent"); asm volatile("s_waitcnt vmcnt(0)" ::: "memory"); }
            __syncthreads();
            norm1_phase(ka->in[I_X], ka->in[I_NORMG], MOD0, MOD0 + D, MODW, WSP(bf16_t, WS_XN), wave, lane);
        }
        const bool two = (int)blockIdx.x + (int)gridDim.x < 320;
        const int n2 = 320 - (int)gridDim.x > 0 ? 320 - (int)gridDim.x : 0;
        const int gw = two ? (int)blockIdx.x * 6 + wave : n2 * 6 + ((int)blockIdx.x - n2) * NWAVES + wave, NGW = n2 * 6 + ((int)gridDim.x - n2) * NWAVES;
        XPOSE_MATS(0x00080003u, (!two || wave < 6), gw, NGW);
        if (blockIdx.x == 0) { for (int i = tid; i < 6 * 32 * 64; i += NTHR) WSP(unsigned, WS_CTL)[i] = 0u; for (int i = tid; i < 4096; i += NTHR) WSP(unsigned, WS_BAR)[i] = 0u; }
        const int gt = blockIdx.x * NTHR + tid, NGT = gridDim.x * NTHR;
        { const int* pos = (const int*)ka->in[I_POS]; float* COS = WSP(float, WS_COS); float* SIN = WSP(float, WS_SIN);
          for (int idx = gt; idx < M * 32; idx += NGT) {
            const int row = idx >> 5, j = idx & 31;
            double inv = 1.0; for (int q = 0; q < j; ++q) inv *= 0.74989420933245582730;
            double sn, cs; sincos_d((double)pos[row] * inv, sn, cs);
            COS[idx] = (float)cs; SIN[idx] = (float)sn;
          } }
        { f32x2* LAM = WSP(f32x2, WS_LAM); f32x2* BBAR = WSP(f32x2, WS_BBAR);
          const float* a_re = ka->in[I_S5ARE]; const float* a_im = ka->in[I_S5AIM]; const float* ldt = ka->in[I_S5LOGDT]; const float* bre = ka->in[I_S5BRE]; const float* bim = ka->in[I_S5BIM];
          for (int it2 = gt; it2 < NG * SP * SH; it2 += NGT) {
            const int idx = it2 >> 4, h = it2 & 15, g = idx >> 6;
            const double are = (double)a_re[idx], aim = (double)a_im[idx];
            const double dt = exp_d((double)ldt[g]);
            double sn, cs; sincos_d(aim * dt, sn, cs);
            const double mag = exp_d(are * dt), lbr = mag * cs, lbi = mag * sn;
            if (h == 0) LAM[idx] = (f32x2){(float)lbr, (float)lbi};
            const double nr = lbr - 1.0, ni = lbi, den = 1.0 / (are * are + aim * aim);
            const double cr = (nr * are + ni * aim) * den, ci = (ni * are - nr * aim) * den;
            const double br = (double)bre[it2], bi = (double)bim[it2];
            BBAR[it2] = (f32x2){(float)(cr * br - ci * bi), (float)(cr * bi + ci * br)};
          } }
    }
    grid.sync();
    XcdBarrier xbar;
    { GETARGS(); xbar = xcd_barrier_post(WSP(unsigned, WS_BAR), (volatile LAS unsigned*)(ldsb + 147200) + 8); }

    for (int s = 0; s < 6; ++s) {
        const int layer = s / 3, sub = s % 3;
        if (sub != 1) {
            const int fi = layer * 2 + (sub >> 1);
            if (s == 3) { GETARGS(); EpiRope E{WSP(bf16_t, WS_K), KVW, WSP(bf16_t, WS_VB), KVW, 1, WSP(float, WS_COS), WSP(float, WS_SIN), 1.0f};
                          pg8::Gemm g_{WSP(bf16_t, WS_XN2), WSP(bf16_t, WS_WKV), M, 2 * KVW, D}; pg8::StaticOrder S_; S_.init(M, 2 * KVW, (int)gridDim.x, (int)((blockIdx.x + 128u) & 255u));
                          pg8::gemm_phase<EpiRope, pg8::StaticOrder, true, true>(ldsb, g_, S_, E); }
            { GETARGS(); EpiSwiGLU E{WSP(bf16_t, WS_H)}; GEMM_PHASE(EpiSwiGLU, E, WSP(bf16_t, WS_XN), WSP(bf16_t, WS_WFFIN) + (size_t)fi * D * 2 * FF, 2 * FF, D); }
            if (gridDim.x == 256) {
                const int first = (s == 3) ? 192 : 128;
                const unsigned mask = (s == 0) ? 0x00040710u : ((s == 2) ? 0x2028u : ((s == 3) ? 0x1840u : 0x0080u));
                if ((int)blockIdx.x >= first) { GETARGS(); LAUNDER_TID(); (void)tid;
                    LAS float* scr = (LAS float*)(ldsb + wave * 16896);
                    XPOSE_MATS(mask, true, ((int)blockIdx.x - first) * NWAVES + wave, (256 - first) * NWAVES); }
            }
        } else if (layer == 0) {
            { GETARGS(); EpiRope E{WSP(bf16_t, WS_V), D, WSP(bf16_t, WS_V), D, 0, WSP(float, WS_COS), WSP(float, WS_SIN), 1.0f}; GEMM_PHASE(EpiRope, E, WSP(bf16_t, WS_XN), WSP(bf16_t, WS_WS5IN), D, D); }
            GSYNC();
            for (int rep_ = 0; rep_ < REP_SCAN; ++rep_) { if (rep_) GSYNC(); GETARGS(); LAUNDER_TID();
                s5_scan_phase(ldsb, WSP(bf16_t, WS_V), WSP(bf16_t, WS_Y), WSP(f32x2, WS_LAM), WSP(f32x2, WS_BBAR), ka->in[I_S5CRE], ka->in[I_S5CIM], ka->in[I_S5D], tid, wave, lane); }
            GSYNC();
            { GETARGS(); EpiGLU E{WSP(bf16_t, WS_Y), WSP(bf16_t, WS_Z), ka->in[I_S5BGLU]}; GEMM_PHASE(EpiGLU, E, WSP(bf16_t, WS_Y), WSP(bf16_t, WS_WS5GLU), D, D); }
        } else {
            { GETARGS(); EpiRope E{WSP(bf16_t, WS_Q), D, WSP(bf16_t, WS_Q), D, 8, WSP(float, WS_COS), WSP(float, WS_SIN), 0.125f * 1.4426950408889634f}; GEMM_PHASE(EpiRope, E, WSP(bf16_t, WS_XN), WSP(bf16_t, WS_WQ), D, D); }
            GSYNC();
            for (int rep_ = 0; rep_ < REP_ATTN; ++rep_) { if (rep_) GSYNC(); GETARGS(); LAUNDER_TID();
                attn_phase(ldsb, WSP(bf16_t, WS_Q), WSP(bf16_t, WS_K), WSP(bf16_t, WS_VB), WSP(bf16_t, WS_O), ka->in[I_SINKS], tid, wave, lane); }
        }
        GSYNC();
        {
            GETARGS();
            int sv = s; asm volatile("" : "+s"(sv));
            const int l0 = sv / 3, sb0 = sv % 3, s1 = sv + 1, l1 = s1 / 3, sb1 = s1 % 3;
            const float* MOD0 = WSP(float, WS_MOD0); const float* MODKV = WSP(float, WS_MODKV); float* X = WSP(float, WS_X);
            const float* modl = MOD0 + (size_t)l0 * (WS_MOD1 / 4) + (size_t)sb0 * (3 * D);
            const float* mod1 = MOD0 + (size_t)l1 * (WS_MOD1 / 4) + (size_t)sb1 * (3 * D);
            const bf16_t* Ares; const bf16_t* Bres; int Kres;
            if (sb0 != 1) { Ares = WSP(bf16_t, WS_H); Bres = WSP(bf16_t, WS_WFFOUT) + (size_t)(l0 * 2 + (sb0 >> 1)) * FF * D; Kres = FF; }
            else if (l0 == 0) { Ares = WSP(bf16_t, WS_Z); Bres = WSP(bf16_t, WS_WS5OUT); Kres = D; }
            else { Ares = WSP(bf16_t, WS_O); Bres = WSP(bf16_t, WS_WO); Kres = D; }
            EpiResidNorm E{(sv == 0) ? ka->in[I_X] : (const float*)X, X, modl + 2 * D, sv,
                           ka->in[I_NORMG], ka->in[I_FING], mod1, mod1 + D, MODW, WSP(bf16_t, WS_XN),
                           ka->in[I_KVG], MODKV, MODKV + D, 2 * D, WSP(bf16_t, WS_XN2), ka->out,
                           WSP(unsigned, WS_XBUF) + (size_t)sv * M * 8, WSP(unsigned, WS_CTL) + (size_t)sv * 32 * 64};
            pg8::Gemm g_{Ares, Bres, M, D, Kres}; pg8::StaticOrder S_; S_.init(M, D, (int)gridDim.x, (int)blockIdx.x);
            pg8::gemm_phase<EpiResidNorm, pg8::StaticOrder, false, true>(ldsb, g_, S_, E);
        }
        if (s < 5) GSYNC();
    }
}

extern "C" void kernel_launch(void* const* d_in, const int* in_sizes, int n_in, void* d_out, int out_size, void* d_ws, size_t ws_size, hipStream_t stream) {
    static int grid = 0;
    if (grid == 0) {
        if (n_in != 28 || out_size != M * D || ws_size < WS_END) { fprintf(stderr, "kernel_launch: unexpected problem (n_in %d, out %d, ws %zu)\n", n_in, out_size, ws_size); grid = -1; return; }
        int dev = 0, cus = 0, per_cu = 0;
        hipGetDevice(&dev); hipDeviceGetAttribute(&cus, hipDeviceAttributeMultiprocessorCount, dev);
        if (hipFuncSetAttribute((const void*)yoco_fwd, hipFuncAttributeMaxDynamicSharedMemorySize, LDS_BYTES) != hipSuccess) { fprintf(stderr, "kernel_launch: hipFuncSetAttribute failed\n"); grid = -1; return; }
        if (hipOccupancyMaxActiveBlocksPerMultiprocessor(&per_cu, (const void*)yoco_fwd, NTHR, LDS_BYTES) != hipSuccess || per_cu < 1) { fprintf(stderr, "kernel_launch: occupancy query gave %d\n", per_cu); per_cu = 1; }
        (void)hipGetLastError();
        grid = cus * per_cu;
        if (grid != 256) { fprintf(stderr, "kernel_launch: need exactly 256 co-resident workgroups, got %d\n", grid); if (grid > 256) grid = 256; else { grid = -1; return; } }
    }
    if (grid < 0) return;
    if (hipMemsetAsync((char*)d_ws + WS_GFLAG, 0, 256, stream) != hipSuccess) { fprintf(stderr, "kernel_launch: memset failed\n"); return; }
    Args a{};
    for (int i = 0; i < 28; ++i) a.in[i] = (const float*)d_in[i];
    a.out = (float*)d_out; a.ws = (unsigned char*)d_ws;
    void* kargs[] = {&a};
    hipError_t e = hipLaunchCooperativeKernel((const void*)yoco_fwd, dim3(grid), dim3(NTHR), kargs, LDS_BYTES, stream);
    if (e != hipSuccess) fprintf(stderr, "kernel_launch: cooperative launch failed: %s (grid %d)\n", hipGetErrorString(e), grid);
}
```
